# Optimizing an MI355X kernel written in HIP

```python
import math
import jax, jax.numpy as jnp
from jax import lax
import numpy as np

D_MODEL = 2048
BATCH = 32
SEQ = 256
DEPTH = 4
DEC_BATCH = 8
DEC_SEQ = 4096
PAST_LEN = 512

GRID_W = 64
N_MIXERS = 2
N_A_LAYERS = (DEPTH + 1) // 2
N_B_LAYERS = DEPTH // 2
BLOCK = 128
A_HEADS = 16
A_KV_HEADS = 4
A_GROUPS = A_HEADS // A_KV_HEADS
A_HEAD_DIM = D_MODEL // A_HEADS
A_WINDOW = 128
B_HEADS = 8
B_QK_DIM = D_MODEL // (2 * B_HEADS)
B_V_DIM = 2 * B_QK_DIM
D_FF = 5632
CONV_WIDTH = 3
ROPE_BASE = 10000.0
EPS = 1e-6
NEG_INF = -1e30

kernel_name = 'hybrid_diffusion_window_sink_diff_attn_convglu'


def _rmsnorm(x, g):
    xf = x.astype(jnp.float32)
    y = xf * lax.rsqrt(jnp.mean(xf * xf, axis=-1, keepdims=True) + EPS)
    return (y * g.astype(jnp.float32)).astype(x.dtype)


def _modulation(cond, w_ada, b_ada):
    m = jax.nn.silu(cond) @ w_ada + b_ada
    return [t[:, None, :] for t in jnp.split(m, 6, axis=-1)]


def _adaln(x, g, shift, scale):
    return _rmsnorm(x, g) * (1 + scale) + shift


def _axial_angles(n, dim):
    rows = n // GRID_W
    row = jnp.repeat(jnp.arange(rows, dtype=jnp.float32), GRID_W)
    col = jnp.tile(jnp.arange(GRID_W, dtype=jnp.float32), rows)
    half = dim // 2
    inv = ROPE_BASE ** (-jnp.arange(0, half, 2, dtype=jnp.float32) / half)
    ang = jnp.concatenate([row[:, None] * inv, col[:, None] * inv], axis=-1)
    return jnp.cos(ang), jnp.sin(ang)


def _rotate(x, cos, sin):
    x1, x2 = jnp.split(x, 2, axis=-1)
    c = cos[None, :, None, :]
    s = sin[None, :, None, :]
    return jnp.concatenate([x1 * c - x2 * s, x2 * c + x1 * s], axis=-1)


def _axial_rope(x, cos, sin):
    half = x.shape[-1] // 2
    quarter = half // 2
    xf = x.astype(jnp.float32)
    out = jnp.concatenate([
        _rotate(xf[..., :half], cos[:, :quarter], sin[:, :quarter]),
        _rotate(xf[..., half:], cos[:, quarter:], sin[:, quarter:])], axis=-1)
    return out.astype(x.dtype)


def _to_blocks(q):
    b, n = q.shape[:2]
    return jnp.moveaxis(q.reshape((b, n // BLOCK, BLOCK) + q.shape[2:]), 1, 0)


def _from_blocks(o):
    nb, b, t, f = o.shape
    return jnp.moveaxis(o, 0, 1).reshape(b, nb * t, f)


def _a_project(h, w_qkv, gq, gk):
    b, n, _ = h.shape
    q, k, v = jnp.split(h @ w_qkv, [A_HEADS * A_HEAD_DIM, (A_HEADS + A_KV_HEADS) * A_HEAD_DIM], axis=-1)
    q = _rmsnorm(q.reshape(b, n, A_HEADS, A_HEAD_DIM), gq)
    k = _rmsnorm(k.reshape(b, n, A_KV_HEADS, A_HEAD_DIM), gk)
    v = v.reshape(b, n, A_KV_HEADS, A_HEAD_DIM)
    return q, k, v


def _gqa_sink_attend(q, k, v, sink, mask):
    b, tq = q.shape[:2]
    s = jnp.einsum('bqkgd,bskd->bkgqs', q.astype(jnp.float32), k.astype(jnp.float32)) * (A_HEAD_DIM ** -0.5)
    if mask is not None:
        s = jnp.where(mask, s, NEG_INF)
    sk = sink.astype(jnp.float32).reshape(1, A_KV_HEADS, A_GROUPS, 1, 1)
    m = jnp.maximum(jnp.max(s, axis=-1, keepdims=True), sk)
    p = jnp.exp(s - m)
    p = p / (jnp.sum(p, axis=-1, keepdims=True) + jnp.exp(sk - m))
    o = jnp.einsum('bkgqs,bskd->bqkgd', p, v.astype(jnp.float32))
    return o.reshape(b, tq, A_HEADS * A_HEAD_DIM).astype(v.dtype)


def _a_context_attention(q, k, v, sink):
    b, n = q.shape[:2]
    qb = _to_blocks(q.reshape(b, n, A_KV_HEADS, A_GROUPS, A_HEAD_DIM))
    o = lax.map(lambda q_blk: _gqa_sink_attend(q_blk, k, v, sink, None), qb)
    return _from_blocks(o)


def _a_latent_attention(q, k, v, k_ctx, v_ctx, sink):
    b, n = q.shape[:2]
    nb = n // BLOCK
    qb = _to_blocks(q.reshape(b, n, A_KV_HEADS, A_GROUPS, A_HEAD_DIM))
    pad = ((0, 0), (A_WINDOW, A_WINDOW), (0, 0), (0, 0))
    k_pad = jnp.pad(k, pad)
    v_pad = jnp.pad(v, pad)
    span = BLOCK + 2 * A_WINDOW
    q_off = jnp.arange(BLOCK)
    k_off = jnp.arange(span) - A_WINDOW
    ctx_mask = jnp.ones((BLOCK, k_ctx.shape[1]), dtype=bool)

    def one_block(args):
        j, q_blk = args
        start = j * BLOCK
        k_win = lax.dynamic_slice_in_dim(k_pad, start, span, axis=1)
        v_win = lax.dynamic_slice_in_dim(v_pad, start, span, axis=1)
        q_pos = start + q_off
        k_pos = start + k_off
        win_mask = ((jnp.abs(q_pos[:, None] - k_pos[None, :]) <= A_WINDOW)
                    & (k_pos >= 0)[None, :] & (k_pos < n)[None, :])
        mask = jnp.concatenate([win_mask, ctx_mask], axis=1)
        k_all = jnp.concatenate([k_win, k_ctx.astype(k_win.dtype)], axis=1)
        v_all = jnp.concatenate([v_win, v_ctx.astype(v_win.dtype)], axis=1)
        return _gqa_sink_attend(q_blk, k_all, v_all, sink, mask)

    o = lax.map(one_block, (jnp.arange(nb), qb))
    return _from_blocks(o)


def _b_project(h, w_qkv, gq, gk):
    b, n, _ = h.shape
    q, k, v = jnp.split(h @ w_qkv, 3, axis=-1)
    q = _rmsnorm(q.reshape(b, n, B_HEADS, 2, B_QK_DIM), gq)
    k = _rmsnorm(k.reshape(b, n, B_HEADS, 2, B_QK_DIM), gk)
    v = v.reshape(b, n, B_HEADS, B_V_DIM)
    return q, k, v


def _b_rope(x, cos, sin):
    b, n = x.shape[:2]
    return _axial_rope(x.reshape(b, n, B_HEADS * 2, B_QK_DIM), cos, sin).reshape(x.shape)


def _diff_attend(q, k, v, lam, subln_g, lambda_init):
    b, tq = q.shape[:2]
    s = jnp.einsum('bqhcd,bshcd->bhcqs', q.astype(jnp.float32), k.astype(jnp.float32)) * (B_QK_DIM ** -0.5)
    a = jax.nn.softmax(s, axis=-1)
    attn = a[:, :, 0] - lam * a[:, :, 1]
    o = jnp.einsum('bhqs,bshd->bqhd', attn, v.astype(jnp.float32))
    o = _rmsnorm(o, subln_g) * (1.0 - lambda_init)
    return o.reshape(b, tq, B_HEADS * B_V_DIM).astype(v.dtype)


def _b_attention(q, k_all, v_all, lam, subln_g, lambda_init):
    o = lax.map(lambda q_blk: _diff_attend(q_blk, k_all, v_all, lam, subln_g, lambda_init), _to_blocks(q))
    return _from_blocks(o)


def _conv_glu(h, w_up, conv_w, conv_b, w_down):
    g, v = jnp.split(h @ w_up, 2, axis=-1)
    n = g.shape[1]
    gp = jnp.pad(g, ((0, 0), (1, 1), (0, 0)))
    gc = gp[:, :n] * conv_w[0] + gp[:, 1:n + 1] * conv_w[1] + gp[:, 2:] * conv_w[2] + conv_b
    return (jax.nn.silu(gc) * v) @ w_down


def setup_inputs(seed: int = 0) -> dict:
    key = jax.random.key(seed)
    ks = jax.random.split(key, 32)
    f32 = jnp.float32

    def nrm(k, shape, scale):
        return jax.random.normal(k, shape, f32) * scale

    qkv_a = (A_HEADS + 2 * A_KV_HEADS) * A_HEAD_DIM
    return {
        'x_prompt': nrm(ks[0], (BATCH, SEQ, D_MODEL), 1.0),
        'x_sample': nrm(ks[1], (DEC_BATCH, DEC_SEQ, D_MODEL), 1.0),
        'cache_a_k': nrm(ks[2], (DEC_BATCH, N_A_LAYERS, PAST_LEN, A_KV_HEADS, A_HEAD_DIM), 1.0),
        'cache_a_v': nrm(ks[3], (DEC_BATCH, N_A_LAYERS, PAST_LEN, A_KV_HEADS, A_HEAD_DIM), 1.0),
        'cache_b_k': nrm(ks[4], (DEC_BATCH, N_B_LAYERS, PAST_LEN, B_HEADS, 2, B_QK_DIM), 1.0),
        'cache_b_v': nrm(ks[5], (DEC_BATCH, N_B_LAYERS, PAST_LEN, B_HEADS, B_V_DIM), 1.0),
        'c': nrm(ks[6], (DEC_BATCH, D_MODEL), 1.0),
        'c_ctx': nrm(ks[7], (D_MODEL,), 1.0),
        'ada_w': nrm(ks[8], (DEPTH, D_MODEL, 6 * D_MODEL), 0.5 * D_MODEL ** -0.5),
        'ada_b': nrm(ks[9], (DEPTH, 6 * D_MODEL), 0.02),
        'norm1_g': 1.0 + nrm(ks[10], (DEPTH, D_MODEL), 0.02),
        'norm2_g': 1.0 + nrm(ks[11], (DEPTH, D_MODEL), 0.02),
        'a_w_qkv': nrm(ks[12], (N_A_LAYERS, D_MODEL, qkv_a), D_MODEL ** -0.5),
        'a_q_norm': 1.0 + nrm(ks[13], (N_A_LAYERS, A_HEAD_DIM), 0.02),
        'a_k_norm': 1.0 + nrm(ks[14], (N_A_LAYERS, A_HEAD_DIM), 0.02),
        'a_sink': nrm(ks[15], (N_A_LAYERS, A_HEADS), 0.5),
        'a_w_o': nrm(ks[16], (N_A_LAYERS, A_HEADS * A_HEAD_DIM, D_MODEL), (A_HEADS * A_HEAD_DIM) ** -0.5),
        'b_w_qkv': nrm(ks[17], (N_B_LAYERS, D_MODEL, 3 * D_MODEL), D_MODEL ** -0.5),
        'b_q_norm': 1.0 + nrm(ks[18], (N_B_LAYERS, B_QK_DIM), 0.02),
        'b_k_norm': 1.0 + nrm(ks[19], (N_B_LAYERS, B_QK_DIM), 0.02),
        'b_lambda_q1': nrm(ks[20], (N_B_LAYERS, B_QK_DIM), 0.1),
        'b_lambda_k1': nrm(ks[21], (N_B_LAYERS, B_QK_DIM), 0.1),
        'b_lambda_q2': nrm(ks[22], (N_B_LAYERS, B_QK_DIM), 0.1),
        'b_lambda_k2': nrm(ks[23], (N_B_LAYERS, B_QK_DIM), 0.1),
        'b_subln': 1.0 + nrm(ks[24], (N_B_LAYERS, B_V_DIM), 0.02),
        'b_w_o': nrm(ks[25], (N_B_LAYERS, B_HEADS * B_V_DIM, D_MODEL), (B_HEADS * B_V_DIM) ** -0.5),
        'ffn_w_up': nrm(ks[26], (DEPTH, D_MODEL, 2 * D_FF), D_MODEL ** -0.5),
        'ffn_conv_w': nrm(ks[27], (DEPTH, CONV_WIDTH, D_FF), CONV_WIDTH ** -0.5),
        'ffn_conv_b': nrm(ks[28], (DEPTH, D_FF), 0.02),
        'ffn_w_down': nrm(ks[29], (DEPTH, D_FF, D_MODEL), D_FF ** -0.5),
    }


def reference(x_prompt, x_sample, cache_a_k, cache_a_v, cache_b_k, cache_b_v, c, c_ctx,
              ada_w, ada_b, norm1_g, norm2_g,
              a_w_qkv, a_q_norm, a_k_norm, a_sink, a_w_o,
              b_w_qkv, b_q_norm, b_k_norm, b_lambda_q1, b_lambda_k1, b_lambda_q2, b_lambda_k2, b_subln, b_w_o,
              ffn_w_up, ffn_conv_w, ffn_conv_b, ffn_w_down):
    n_lat = x_sample.shape[1]
    cos_a, sin_a = _axial_angles(n_lat, A_HEAD_DIM)
    cos_b, sin_b = _axial_angles(n_lat, B_QK_DIM)
    xp = x_prompt
    xs = x_sample
    a_k_list, a_v_list, b_k_list, b_v_list = [], [], [], []

    for i in range(DEPTH):
        sh1_p, sc1_p, g1_p, sh2_p, sc2_p, g2_p = _modulation(c_ctx[None, :], ada_w[i], ada_b[i])
        sh1_s, sc1_s, g1_s, sh2_s, sc2_s, g2_s = _modulation(c, ada_w[i], ada_b[i])
        hp = _adaln(xp, norm1_g[i], sh1_p, sc1_p)
        hs = _adaln(xs, norm1_g[i], sh1_s, sc1_s)
        j = i // N_MIXERS
        if i % N_MIXERS == 0:
            qp, kp, vp = _a_project(hp, a_w_qkv[j], a_q_norm[j], a_k_norm[j])
            op = _a_context_attention(qp, kp, vp, a_sink[j]) @ a_w_o[j]
            qs, ks_, vs = _a_project(hs, a_w_qkv[j], a_q_norm[j], a_k_norm[j])
            qs = _axial_rope(qs, cos_a, sin_a)
            ks_ = _axial_rope(ks_, cos_a, sin_a)
            os_ = _a_latent_attention(qs, ks_, vs, cache_a_k[:, j], cache_a_v[:, j], a_sink[j]) @ a_w_o[j]
            a_k_list.append(kp)
            a_v_list.append(vp)
        else:
            lambda_init = 0.8 - 0.6 * math.exp(-0.3 * i)
            lam = (jnp.exp(jnp.sum(b_lambda_q1[j].astype(jnp.float32) * b_lambda_k1[j].astype(jnp.float32)))
                   - jnp.exp(jnp.sum(b_lambda_q2[j].astype(jnp.float32) * b_lambda_k2[j].astype(jnp.float32)))
                   + lambda_init)
            qp, kp, vp = _b_project(hp, b_w_qkv[j], b_q_norm[j], b_k_norm[j])
            op = _b_attention(qp, kp, vp, lam, b_subln[j], lambda_init) @ b_w_o[j]
            qs, ks_, vs = _b_project(hs, b_w_qkv[j], b_q_norm[j], b_k_norm[j])
            qs = _b_rope(qs, cos_b, sin_b)
            ks_ = _b_rope(ks_, cos_b, sin_b)
            k_all = jnp.concatenate([ks_, cache_b_k[:, j].astype(ks_.dtype)], axis=1)
            v_all = jnp.concatenate([vs, cache_b_v[:, j].astype(vs.dtype)], axis=1)
            os_ = _b_attention(qs, k_all, v_all, lam, b_subln[j], lambda_init) @ b_w_o[j]
            b_k_list.append(kp)
            b_v_list.append(vp)
        xp = xp + g1_p * op
        xs = xs + g1_s * os_
        hp = _adaln(xp, norm2_g[i], sh2_p, sc2_p)
        hs = _adaln(xs, norm2_g[i], sh2_s, sc2_s)
        xp = xp + g2_p * _conv_glu(hp, ffn_w_up[i], ffn_conv_w[i], ffn_conv_b[i], ffn_w_down[i])
        xs = xs + g2_s * _conv_glu(hs, ffn_w_up[i], ffn_conv_w[i], ffn_conv_b[i], ffn_w_down[i])

    state_a_k = jnp.stack(a_k_list, axis=1)
    state_a_v = jnp.stack(a_v_list, axis=1)
    state_b_k = jnp.stack(b_k_list, axis=1)
    state_b_v = jnp.stack(b_v_list, axis=1)
    return (xp, xs, state_a_k, state_a_v, state_b_k, state_b_v)
```

```cpp
#include <hip/hip_runtime.h>
#include <cstdio>
#include <cstdint>
#include <cmath>
namespace pg8 {
#define PG8_LAS __attribute__((address_space(3)))
typedef unsigned short bf16_t;
typedef short bf16x8 __attribute__((ext_vector_type(8)));
typedef float f32x4 __attribute__((ext_vector_type(4)));
typedef unsigned u32x4 __attribute__((ext_vector_type(4)));
constexpr int BM = 256, BK = 64, HALF = 128, HTB = HALF * BK * 2  , STAGE_BYTES = 8 * HTB, NXCD = 8, WGM = 8;

__host__ __device__ __forceinline__ int lds_byte(int r, int c) { const int st = (r >> 4) * 2 + (c >> 5), rr = r & 15, cc = c & 31, ob = rr * 64 + cc * 2; return st * 1024 + (ob ^ (((ob >> 9) & 1) << 5)); }
__host__ __device__ __forceinline__ void stage_rc(int b, int& R, int& C) { const int st = b / 1024, sb = b % 1024, swz = sb ^ (((sb >> 9) & 1) << 5); R = (st >> 1) * 16 + swz / 64; C = (st & 1) * 32 + (swz % 64) / 2; }
__host__ __device__ __forceinline__ int perm32(int rho) { const int n = rho >> 4, i = rho & 15; return 8 * (i >> 2) + 4 * n + (i & 3); }

struct Unit { int pm, pn; };
struct Gemm { const bf16_t* A; const bf16_t* Bt; int M, N, K; };

struct StaticOrder {
    int nM, nN, nwg, G, c, wgm;
    __host__ __device__ void init(int M, int N, int G_, int c_, int wgm_ = WGM) { nM = M / BM; nN = N / BM; nwg = nM * nN; G = G_; c = c_; wgm = wgm_; }
    __host__ __device__ bool next(int i, Unit& u) const {
        const long L = (long)i * G + c; if (L >= nwg) return false;
        int wgid = (int)L; { const int q = nwg / NXCD, r = nwg % NXCD, xcd = wgid % NXCD, off = wgid / NXCD; wgid = (xcd < r ? xcd * (q + 1) : r * (q + 1) + (xcd - r) * q) + off; }
        const int nig = wgm * nN, gid = wgid / nig, fm = gid * wgm, gsz = (nM - fm) < wgm ? (nM - fm) : wgm;
        u.pm = fm + ((wgid % nig) % gsz); u.pn = (wgid % nig) / gsz; return true;
    }
    __device__ __forceinline__ void a_ready(const Unit&) const {}
    __device__ __forceinline__ void done(const Unit&) const {}
};

__device__ __forceinline__ unsigned cvt_pk_bf16(float lo, float hi) { unsigned r; asm volatile("v_cvt_pk_bf16_f32 %0, %1, %2" : "=v"(r) : "v"(lo), "v"(hi)); return r; }
typedef float f32x2 __attribute__((ext_vector_type(2)));
struct EpiBf16 {
    static constexpr bool PERM = true, AFTER_DRAIN = false;
    bf16_t* O; int ldc;
    __device__ __forceinline__ void operator()(const f32x4 (&acc)[2][2][4][2], const Unit& u, int wr, int wc, int fr, int fq) const {
        const int row0 = u.pm * BM + wr * 64 + fr, col0 = u.pn * BM + wc * 32 + 8 * fq;
#pragma unroll
        for (int ai = 0; ai < 2; ++ai)
#pragma unroll
            for (int m = 0; m < 4; ++m) { bf16_t* rowp = O + (size_t)(row0 + ai * HALF + m * 16) * ldc + col0;
#pragma unroll
                for (int bj = 0; bj < 2; ++bj) { const f32x4 v0 = acc[ai][bj][m][0], v1 = acc[ai][bj][m][1];
                    u32x4 w; w.x = cvt_pk_bf16(v0[0], v0[1]); w.y = cvt_pk_bf16(v0[2], v0[3]); w.z = cvt_pk_bf16(v1[0], v1[1]); w.w = cvt_pk_bf16(v1[2], v1[3]);
                    *(u32x4*)(rowp + bj * HALF) = w; } }
    }
};
struct EpiGate {
    static constexpr bool PERM = true, AFTER_DRAIN = false;
    float* X; const float* gate;
    bf16_t* An; const float* gn; const float* sc; float* rowss; PG8_LAS float* red;
    __device__ __forceinline__ void operator()(const f32x4 (&acc)[2][2][4][2], const Unit& u, int wr, int wc, int fr, int fq) const {
        const int row0 = u.pm * BM + wr * 64 + fr, col0 = u.pn * BM + wc * 32 + 8 * fq;
        const int cond = (u.pm < 32) ? 8 : ((u.pm - 32) >> 4);
        const float* gp = gate + (size_t)cond * 12288 + col0;
        const bool nn = An != nullptr;
        float ssq[2][4];
#pragma unroll
        for (int ai = 0; ai < 2; ++ai)
#pragma unroll
            for (int m = 0; m < 4; ++m) ssq[ai][m] = 0.f;
#pragma unroll
        for (int bj = 0; bj < 2; ++bj) {
            const f32x4 g0 = *(const f32x4*)(gp + bj * HALF), g1 = *(const f32x4*)(gp + bj * HALF + 4);
            f32x4 s0 = (f32x4){0.f, 0.f, 0.f, 0.f}, s1 = s0;
            if (nn) { const float* gnp = gn + col0 + bj * HALF; const float* scp = sc + (size_t)cond * 12288 + col0 + bj * HALF;
                s0 = *(const f32x4*)gnp * (*(const f32x4*)scp + 1.0f); s1 = *(const f32x4*)(gnp + 4) * (*(const f32x4*)(scp + 4) + 1.0f); }
#pragma unroll
            for (int ai = 0; ai < 2; ++ai) {
                float* colp = X + (size_t)(row0 + ai * HALF) * 2048 + col0 + bj * HALF;
                f32x4 xv[4][2];
#pragma unroll
                for (int m = 0; m < 4; ++m) { xv[m][0] = *(const f32x4*)(colp + (size_t)(m * 16) * 2048); xv[m][1] = *(const f32x4*)(colp + (size_t)(m * 16) * 2048 + 4); }
#pragma unroll
                for (int m = 0; m < 4; ++m) { const f32x4 a = xv[m][0] + g0 * acc[ai][bj][m][0], b = xv[m][1] + g1 * acc[ai][bj][m][1];
                    *(f32x4*)(colp + (size_t)(m * 16) * 2048) = a; *(f32x4*)(colp + (size_t)(m * 16) * 2048 + 4) = b;
                    if (nn) { ssq[ai][m] += ((a[0] * a[0] + a[1] * a[1]) + (a[2] * a[2] + a[3] * a[3])) + ((b[0] * b[0] + b[1] * b[1]) + (b[2] * b[2] + b[3] * b[3]));
                        const f32x4 ya = a * s0, yb = b * s1; u32x4 w; w.x = cvt_pk_bf16(ya[0], ya[1]); w.y = cvt_pk_bf16(ya[2], ya[3]); w.z = cvt_pk_bf16(yb[0], yb[1]); w.w = cvt_pk_bf16(yb[2], yb[3]);
                        *(u32x4*)(An + (size_t)(row0 + ai * HALF + m * 16) * 2048 + col0 + bj * HALF) = w; } }
                asm volatile("" ::: "memory"); } }
        if (nn) {
#pragma unroll
            for (int ai = 0; ai < 2; ++ai)
#pragma unroll
                for (int m = 0; m < 4; ++m) { float s = ssq[ai][m]; s += __shfl_xor(s, 16); s += __shfl_xor(s, 32);
                    if (fq == 0) red[(ai * HALF + wr * 64 + m * 16 + fr) * 4 + wc] = s; }
            asm volatile("s_waitcnt lgkmcnt(0)" ::: "memory"); __builtin_amdgcn_s_barrier(); asm volatile("" ::: "memory");
            const int t = (wr * 4 + wc) * 64 + fq * 16 + fr;
            if (t < 256) { const f32x4 pr = *(const PG8_LAS f32x4*)(red + t * 4); rowss[(size_t)(u.pm * BM + t) * 8 + u.pn] = (pr[0] + pr[1]) + (pr[2] + pr[3]); } }
    }
};
__device__ __forceinline__ float rstd_of(const float* s8) { const f32x4 a = *(const f32x4*)s8, b = *(const f32x4*)(s8 + 4); return 1.0f / sqrtf((((a[0] + a[1]) + (a[2] + a[3])) + ((b[0] + b[1]) + (b[2] + b[3]))) * (1.0f / 2048.0f) + 1e-6f); }

struct EpiConvGlu {
    static constexpr bool PERM = true, AFTER_DRAIN = false;
    bf16_t* ACT; const float* cw; const float* cb; float* EDGE; PG8_LAS float* xg;
    const float* rowss; const float* shw;
    __device__ __forceinline__ void operator()(f32x4 (&acc)[2][2][4][2], const Unit& u, int wr, int wc, int fr, int fq) const {
        const int cl = wc * 32 + 8 * fq, f0 = u.pn * 128 + cl;
        { const int cond = (u.pm < 32) ? 8 : ((u.pm - 32) >> 4);
          const float* sp = shw + (size_t)cond * 11264 + u.pn * BM + cl;
          { const int t = (wr * 4 + wc) * 64 + fq * 16 + fr;
            if (t < 256) xg[256 + t] = rstd_of(rowss + (size_t)(u.pm * BM + t) * 8);
            asm volatile("s_waitcnt lgkmcnt(0)" ::: "memory"); __builtin_amdgcn_s_barrier(); asm volatile("" ::: "memory"); }
          float rs[8];
          { const f32x4 r0 = *(const PG8_LAS f32x4*)(xg + 256 + 8 * (16 * wr + fr)), r1 = *(const PG8_LAS f32x4*)(xg + 256 + 8 * (16 * wr + fr) + 4);
            rs[0] = r0[0]; rs[1] = r0[1]; rs[2] = r0[2]; rs[3] = r0[3]; rs[4] = r1[0]; rs[5] = r1[1]; rs[6] = r1[2]; rs[7] = r1[3]; }
#pragma unroll
          for (int bj = 0; bj < 2; ++bj)
#pragma unroll
              for (int n = 0; n < 2; ++n) { const f32x4 sh = *(const f32x4*)(sp + bj * HALF + 4 * n);
#pragma unroll
                  for (int ai = 0; ai < 2; ++ai)
#pragma unroll
                      for (int m = 0; m < 4; ++m) acc[ai][bj][m][n] = acc[ai][bj][m][n] * rs[4 * ai + m] + sh; } }
        if (wr == 1 && fr == 0)  { *(PG8_LAS f32x4*)(xg + cl) = acc[0][0][0][0]; *(PG8_LAS f32x4*)(xg + cl + 4) = acc[0][0][0][1]; }
        if (wr == 0 && fr == 15) { *(PG8_LAS f32x4*)(xg + 128 + cl) = acc[1][0][3][0]; *(PG8_LAS f32x4*)(xg + 128 + cl + 4) = acc[1][0][3][1]; }
        asm volatile("s_waitcnt lgkmcnt(0)" ::: "memory"); __builtin_amdgcn_s_barrier(); asm volatile("" ::: "memory");
        f32x4 w0[2], w1[2], w2[2], bb[2], prv[2], nxt[2];
#pragma unroll
        for (int n = 0; n < 2; ++n) { w0[n] = *(const f32x4*)(cw + f0 + 4 * n); w1[n] = *(const f32x4*)(cw + 5632 + f0 + 4 * n); w2[n] = *(const f32x4*)(cw + 2 * 5632 + f0 + 4 * n); bb[n] = *(const f32x4*)(cb + f0 + 4 * n); }
#pragma unroll
        for (int n = 0; n < 2; ++n)
#pragma unroll
            for (int j = 0; j < 4; ++j) {
                const float up_ = acc[1][0][3][n][j], dn_ = acc[0][0][0][n][j];
                prv[n][j] = __int_as_float(__builtin_amdgcn_update_dpp(0, __float_as_int(up_), 0x111, 0xf, 0xf, false));
                nxt[n][j] = __int_as_float(__builtin_amdgcn_update_dpp(0, __float_as_int(dn_), 0x101, 0xf, 0xf, false)); }
        if (fr == 0) {
#pragma unroll
            for (int n = 0; n < 2; ++n) prv[n] = (wr == 1) ? *(const PG8_LAS f32x4*)(xg + 128 + cl + 4 * n) : (f32x4){0.f, 0.f, 0.f, 0.f}; }
        if (fr == 15) {
#pragma unroll
            for (int n = 0; n < 2; ++n) nxt[n] = (wr == 0) ? *(const PG8_LAS f32x4*)(xg + cl + 4 * n) : (f32x4){0.f, 0.f, 0.f, 0.f}; }
        float* eb = EDGE + (size_t)u.pm * 6 * 5632 + f0;
        if (wr == 1 && fr == 15) {
#pragma unroll
            for (int n = 0; n < 2; ++n) { *(f32x4*)(eb + 0 * 5632 + 4 * n) = acc[1][0][2][n]; *(f32x4*)(eb + 1 * 5632 + 4 * n) = acc[1][0][3][n]; *(f32x4*)(eb + 2 * 5632 + 4 * n) = acc[1][1][3][n]; } }
        if (wr == 0 && fr == 0) {
#pragma unroll
            for (int n = 0; n < 2; ++n) { *(f32x4*)(eb + 3 * 5632 + 4 * n) = acc[0][0][0][n]; *(f32x4*)(eb + 4 * 5632 + 4 * n) = acc[0][0][1][n]; *(f32x4*)(eb + 5 * 5632 + 4 * n) = acc[0][1][0][n]; } }
        bf16_t* op = ACT + (size_t)(u.pm * BM + 8 * (16 * wr + fr)) * 5632 + f0;
#pragma unroll
        for (int tau = 0; tau < 8; ++tau) {
            unsigned w[4];
#pragma unroll
            for (int n = 0; n < 2; ++n) {
                const int tm = tau == 0 ? 0 : tau - 1, tp = tau == 7 ? 7 : tau + 1;
                const f32x4 xm = (tau == 0) ? prv[n] : acc[tm >> 2][0][tm & 3][n];
                const f32x4 xc = acc[tau >> 2][0][tau & 3][n];
                const f32x4 xp = (tau == 7) ? nxt[n] : acc[tp >> 2][0][tp & 3][n];
                const f32x4 vv = acc[tau >> 2][1][tau & 3][n];
                const f32x4 s = __builtin_elementwise_fma(w2[n], xp, __builtin_elementwise_fma(w1[n], xc, __builtin_elementwise_fma(w0[n], xm, bb[n])));
                const f32x4 tq = s * -1.4426950408889634f;
                f32x4 e4; e4[0] = __builtin_amdgcn_exp2f(tq[0]); e4[1] = __builtin_amdgcn_exp2f(tq[1]); e4[2] = __builtin_amdgcn_exp2f(tq[2]); e4[3] = __builtin_amdgcn_exp2f(tq[3]);
                const f32x4 d4 = e4 + 1.0f;
                f32x4 r4; r4[0] = __builtin_amdgcn_rcpf(d4[0]); r4[1] = __builtin_amdgcn_rcpf(d4[1]); r4[2] = __builtin_amdgcn_rcpf(d4[2]); r4[3] = __builtin_amdgcn_rcpf(d4[3]);
                const f32x4 a = (s * vv) * r4;
                w[2 * n] = cvt_pk_bf16(a[0], a[1]); w[2 * n + 1] = cvt_pk_bf16(a[2], a[3]);
            }
            u32x4 o; o.x = w[0]; o.y = w[1]; o.z = w[2]; o.w = w[3];
            *(u32x4*)(op + (size_t)tau * 5632) = o;
        }
    }
};

__host__ __device__ __forceinline__ int qk_row_of_dim(int d) { const int i = d & 31; return 32 * (2 * (d >> 6) + (i >> 4)) + 8 * ((i >> 2) & 3) + 4 * ((d >> 5) & 1) + (d & 3); }
struct EpiQKV {
    static constexpr bool PERM = true, AFTER_DRAIN = false;
    bf16_t* O; int ldc, nqk;
    const float* gq; const float* gk; const float* tab;
    float* SK; float* SV; int kvw, jl;
    PG8_LAS float* red;
    const float* rowss; const float* shw;
    __device__ __forceinline__ void operator()(f32x4 (&acc)[2][2][4][2], const Unit& u, int wr, int wc, int fr, int fq) const {
        typedef unsigned u32x2v __attribute__((ext_vector_type(2)));
        const int v0 = 2 * u.pn; const bool ctx = u.pm < 32;
        { const int cond = ctx ? 8 : ((u.pm - 32) >> 4);
          const float* sp = shw + (size_t)cond * ldc + u.pn * BM + wc * 32 + 8 * fq;
          { const int t = (wr * 4 + wc) * 64 + fq * 16 + fr;
            if (t < 256) red[2560 + t] = rstd_of(rowss + (size_t)(u.pm * BM + t) * 8);
            asm volatile("s_waitcnt lgkmcnt(0)" ::: "memory"); __builtin_amdgcn_s_barrier(); asm volatile("" ::: "memory"); }
          float rs[2][4];
#pragma unroll
          for (int ai = 0; ai < 2; ++ai)
#pragma unroll
              for (int m = 0; m < 4; ++m) rs[ai][m] = red[2560 + ai * HALF + wr * 64 + m * 16 + fr];
#pragma unroll
          for (int bj = 0; bj < 2; ++bj)
#pragma unroll
              for (int n = 0; n < 2; ++n) { const f32x4 sh = *(const f32x4*)(sp + bj * HALF + 4 * n);
#pragma unroll
                  for (int ai = 0; ai < 2; ++ai)
#pragma unroll
                      for (int m = 0; m < 4; ++m) acc[ai][bj][m][n] = acc[ai][bj][m][n] * rs[ai][m] + sh; } }
        const bool qk0 = v0 < nqk, qk1 = v0 + 1 < nqk;
        if (qk0 || qk1) {
#pragma unroll
            for (int bj = 0; bj < 2; ++bj) if (bj ? qk1 : qk0) {
#pragma unroll
                for (int ai = 0; ai < 2; ++ai)
#pragma unroll
                    for (int m = 0; m < 4; ++m) { const f32x4 a = acc[ai][bj][m][0], b = acc[ai][bj][m][1];
                        float s = (a[0] * a[0] + a[1] * a[1]) + (a[2] * a[2] + a[3] * a[3]) + (b[0] * b[0] + b[1] * b[1]) + (b[2] * b[2] + b[3] * b[3]);
                        s += __shfl_xor(s, 16); s += __shfl_xor(s, 32);
                        if (fq == 0) red[((ai * HALF + wr * 64 + m * 16 + fr) * 2 + bj) * 4 + wc] = s; } }
            asm volatile("s_waitcnt lgkmcnt(0)" ::: "memory"); __builtin_amdgcn_s_barrier(); asm volatile("" ::: "memory");
            { const int t = (wr * 4 + wc) * 64 + fq * 16 + fr;
              const f32x4 pr = *(const PG8_LAS f32x4*)(red + t * 4);
              red[2048 + t] = 1.0f / sqrtf(((pr[0] + pr[1]) + (pr[2] + pr[3])) * (1.0f / 128.0f) + 1e-6f); }
            asm volatile("s_waitcnt lgkmcnt(0)" ::: "memory"); __builtin_amdgcn_s_barrier(); asm volatile("" ::: "memory");
        }
        const int d1 = 64 * (wc >> 1) + 16 * (wc & 1) + 4 * fq, i0 = 16 * (wc & 1) + 4 * fq, tr0 = wr * 64 + fr;
        const unsigned ldb = (unsigned)ldc * 2u, kvb = (unsigned)kvw * 4u;
        const unsigned srow0 = (unsigned)((u.pm * 2 + jl) * 256 + tr0);
#pragma unroll
        for (int bj = 0; bj < 2; ++bj) {
            const int vec = v0 + bj;
            if (bj ? qk1 : qk0) {
                const float* g = vec < 16 ? gq : gk;
                const f32x4 g1 = *(const f32x4*)(g + d1), g2 = *(const f32x4*)(g + d1 + 32);
                const unsigned ob = (unsigned)(u.pm * BM + tr0) * ldb + (unsigned)(vec * 128 + d1) * 2u;
                const unsigned sb = srow0 * kvb + (unsigned)((vec - 16) * 128 + d1) * 4u;
#pragma unroll
                for (int ai = 0; ai < 2; ++ai)
#pragma unroll
                    for (int m = 0; m < 4; ++m) { const int dr = ai * HALF + m * 16;
                        const float rstd = red[2048 + (tr0 + dr) * 2 + bj];
                        f32x4 x1 = acc[ai][bj][m][0] * rstd * g1, x2 = acc[ai][bj][m][1] * rstd * g2;
                        if (!ctx) { const int p = (wc >> 1) ? (16 * m + fr) : (((u.pm - 32) * 4 + 2 * ai + wr) & 63);
                            const f32x4 c = *(const f32x4*)(tab + (unsigned)(p * 64 + i0)), s = *(const f32x4*)(tab + (unsigned)(p * 64 + 32 + i0));
                            const f32x4 y1 = x1 * c - x2 * s, y2 = x2 * c + x1 * s; x1 = y1; x2 = y2; }
                        u32x2v w1, w2; w1.x = cvt_pk_bf16(x1[0], x1[1]); w1.y = cvt_pk_bf16(x1[2], x1[3]); w2.x = cvt_pk_bf16(x2[0], x2[1]); w2.y = cvt_pk_bf16(x2[2], x2[3]);
                        char* op = (char*)O + (size_t)(ob + (unsigned)dr * ldb);
                        *(u32x2v*)op = w1; *(u32x2v*)(op + 64) = w2;
                        if (ctx && vec >= 16) { char* sp = (char*)SK + (size_t)(sb + (unsigned)dr * kvb); *(f32x4*)sp = x1; *(f32x4*)(sp + 128) = x2; }
                        if (m & 1) asm volatile("" ::: "memory");
                    }
            } else {
                const int cl = wc * 32 + 8 * fq;
                const unsigned ob = (unsigned)(u.pm * BM + tr0) * ldb + (unsigned)(vec * 128 + cl) * 2u;
                const unsigned sb = srow0 * kvb + (unsigned)((vec - nqk) * 128 + cl) * 4u;
#pragma unroll
                for (int ai = 0; ai < 2; ++ai)
#pragma unroll
                    for (int m = 0; m < 4; ++m) { const int dr = ai * HALF + m * 16; const f32x4 a = acc[ai][bj][m][0], b = acc[ai][bj][m][1];
                        u32x4 w; w.x = cvt_pk_bf16(a[0], a[1]); w.y = cvt_pk_bf16(a[2], a[3]); w.z = cvt_pk_bf16(b[0], b[1]); w.w = cvt_pk_bf16(b[2], b[3]);
                        *(u32x4*)((char*)O + (size_t)(ob + (unsigned)dr * ldb)) = w;
                        if (ctx) { char* sp = (char*)SV + (size_t)(sb + (unsigned)dr * kvb); *(f32x4*)sp = a; *(f32x4*)(sp + 16) = b; }
                    }
            }
        }
    }
};

template <class Epi, class Sched, bool ALIGN_EPI = false, bool SP2 = false, bool ROWPERM = false  >
__device__ __forceinline__ void gemm_phase(PG8_LAS unsigned char* lds, const Gemm g, const Sched& S, const Epi& E, const int wave_id  ) {
    int tid_ = (wave_id << 6) | (int)__builtin_amdgcn_mbcnt_hi(~0u, __builtin_amdgcn_mbcnt_lo(~0u, 0u)); asm volatile("" : "+v"(tid_));
    const int tid = tid_, wid = __builtin_amdgcn_readfirstlane(tid >> 6), lane = tid & 63, wr = wid >> 2, wc = wid & 3, fr = lane & 15, fq = lane >> 4;
    const int K = g.K, nt = K / BK;
    unsigned voffA[2], voffB[2];
#pragma unroll
    for (int i = 0; i < 2; ++i) { int R, C; stage_rc(tid * 16 + i * 8192, R, C); const int Rb = Epi::PERM ? ((R & ~31) + perm32(R & 31)) : R;
        const int Ra = ROWPERM ? (8 * (16 * (R >> 6) + (R & 15)) + ((R >> 4) & 3)) : R;
        voffA[i] = (unsigned)(Ra * K + C) * 2u; voffB[i] = (unsigned)(Rb * K + C) * 2u; }
    const size_t kstep = (size_t)(BK * 2);
    const size_t hstep = (size_t)HALF * K * 2;
    const size_t tstep = 2 * hstep;
    const size_t hstepA = ROWPERM ? (size_t)4 * K * 2 : hstep;
    const unsigned ldsw = (unsigned)wid * 1024u;
    const int aoff = lds_byte(wr * 64 + fr, fq * 8), boff = lds_byte(wc * 32 + fr, fq * 8);
#define PG8_SA(b, h) (((b) * 2 + (h)) * HTB)
#define PG8_SB(b, h) ((4 + (b) * 2 + (h)) * HTB)
#define PG8_STAGE(bufoff, gbase, voff) do { _Pragma("unroll") for (int _i = 0; _i < 2; ++_i) \
        __builtin_amdgcn_global_load_lds((const unsigned*)((const char*)(gbase) + (voff)[_i]), (PG8_LAS unsigned*)(lds + (bufoff) + ldsw + _i * 8192), 16, 0, 0); } while (0)
#define PG8_LDA(dst, b, h) do { _Pragma("unroll") for (int m = 0; m < 4; ++m) _Pragma("unroll") for (int k = 0; k < 2; ++k) dst[m][k] = *(const PG8_LAS bf16x8*)(lds + PG8_SA(b, h) + aoff + m * 2048 + k * 1024); } while (0)
#define PG8_LDB(dst, b, h) do { _Pragma("unroll") for (int n = 0; n < 2; ++n) _Pragma("unroll") for (int k = 0; k < 2; ++k) dst[n][k] = *(const PG8_LAS bf16x8*)(lds + PG8_SB(b, h) + boff + n * 2048 + k * 1024); } while (0)
#define PG8_MMA(ai, bj, At, Bt) do { __builtin_amdgcn_s_setprio(1); _Pragma("unroll") for (int m = 0; m < 4; ++m) _Pragma("unroll") for (int n = 0; n < 2; ++n) _Pragma("unroll") for (int k = 0; k < 2; ++k) \
        acc[ai][bj][m][n] = __builtin_amdgcn_mfma_f32_16x16x32_bf16(Bt[n][k], At[m][k], acc[ai][bj][m][n], 0, 0, 0); __builtin_amdgcn_s_setprio(0); } while (0)
#define PG8_WAIT_V(n) asm volatile("s_waitcnt vmcnt(" #n ")" ::: "memory")
#define PG8_WAIT_L(n) asm volatile("s_waitcnt lgkmcnt(" #n ")" ::: "memory")
#define PG8_BAR __builtin_amdgcn_s_barrier()
#define PG8_SCHED __builtin_amdgcn_sched_barrier(0)
    Unit cur, nxt; int ui = 0;
    if (!S.next(0, cur)) return;
    f32x4 acc[2][2][4][2];
#pragma unroll
    for (int a = 0; a < 2; ++a)
#pragma unroll
        for (int b = 0; b < 2; ++b)
#pragma unroll
            for (int m = 0; m < 4; ++m)
#pragma unroll
                for (int n = 0; n < 2; ++n) acc[a][b][m][n] = (f32x4){0.f, 0.f, 0.f, 0.f};
    bf16x8 At[4][2], B0[2][2], B1[2][2];
    const char* cA = (const char*)g.A + (size_t)cur.pm * tstep; const char* cB = (const char*)g.Bt + (size_t)cur.pn * tstep;
    S.a_ready(cur);
    if constexpr (SP2) {
        PG8_STAGE(PG8_SB(0, 0), cB, voffB); PG8_STAGE(PG8_SB(0, 1), cB + hstep, voffB); PG8_STAGE(PG8_SA(0, 0), cA, voffA); PG8_STAGE(PG8_SA(0, 1), cA + hstepA, voffA);
        if (wr == 1) PG8_BAR;
        PG8_WAIT_V(2); PG8_BAR;
        PG8_STAGE(PG8_SB(1, 0), cB + kstep, voffB); PG8_STAGE(PG8_SA(1, 0), cA + kstep, voffA); PG8_STAGE(PG8_SB(1, 1), cB + hstep + kstep, voffB);
        PG8_WAIT_V(6); PG8_BAR;
    } else {
        PG8_STAGE(PG8_SB(0, 0), cB, voffB); PG8_STAGE(PG8_SA(0, 0), cA, voffA); PG8_STAGE(PG8_SB(0, 1), cB + hstep, voffB); PG8_STAGE(PG8_SA(0, 1), cA + hstepA, voffA);
        if (wr == 1) PG8_BAR;
        PG8_WAIT_V(4); PG8_BAR;
        PG8_STAGE(PG8_SB(1, 0), cB + kstep, voffB); PG8_STAGE(PG8_SA(1, 0), cA + kstep, voffA); PG8_STAGE(PG8_SB(1, 1), cB + hstep + kstep, voffB);
        PG8_WAIT_V(6); PG8_BAR;
    }
    for (;;) {
        const bool has_next = S.next(ui + 1, nxt);
        const char* nA = has_next ? (const char*)g.A + (size_t)nxt.pm * tstep : cA; const char* nB = has_next ? (const char*)g.Bt + (size_t)nxt.pn * tstep : cB;
        for (int t = 0; t < nt; t += 2) {
            const bool last = (t == nt - 2);
            const char* a1 = cA + (size_t)(t + 1) * kstep;
            const char* a2 = last ? nA : cA + (size_t)(t + 2) * kstep; const char* b2 = last ? nB : cB + (size_t)(t + 2) * kstep;
            const char* a3 = a2 + kstep; const char* b3 = b2 + kstep;
            if (last && has_next) S.a_ready(nxt);
            if constexpr (SP2) {
            PG8_LDB(B0, 0, 0); PG8_LDB(B1, 0, 1); PG8_SCHED; PG8_LDA(At, 0, 0); PG8_STAGE(PG8_SA(1, 1), a1 + hstepA, voffA);
            PG8_WAIT_V(8); PG8_WAIT_L(0); PG8_BAR; PG8_MMA(0, 0, At, B0); PG8_MMA(0, 1, At, B1); PG8_BAR; PG8_SCHED;
            PG8_LDA(At, 0, 1); PG8_STAGE(PG8_SB(0, 0), b2, voffB); PG8_STAGE(PG8_SB(0, 1), b2 + hstep, voffB); PG8_STAGE(PG8_SA(0, 0), a2, voffA);
            PG8_WAIT_V(8); PG8_WAIT_L(0); PG8_BAR; PG8_MMA(1, 0, At, B0); PG8_MMA(1, 1, At, B1); PG8_BAR; PG8_SCHED;
            PG8_LDB(B0, 1, 0); PG8_LDB(B1, 1, 1); PG8_SCHED; PG8_LDA(At, 1, 0); PG8_STAGE(PG8_SA(0, 1), a2 + hstepA, voffA);
            PG8_WAIT_V(8); PG8_WAIT_L(0); PG8_BAR; PG8_MMA(0, 0, At, B0); PG8_MMA(0, 1, At, B1); PG8_BAR; PG8_SCHED;
            PG8_LDA(At, 1, 1); PG8_STAGE(PG8_SB(1, 0), b3, voffB); PG8_STAGE(PG8_SB(1, 1), b3 + hstep, voffB); PG8_STAGE(PG8_SA(1, 0), a3, voffA);
            PG8_WAIT_V(8); PG8_WAIT_L(0); PG8_BAR; PG8_MMA(1, 0, At, B0); PG8_MMA(1, 1, At, B1); PG8_BAR; PG8_SCHED;
            } else {
            PG8_LDB(B0, 0, 0); PG8_SCHED; PG8_LDA(At, 0, 0); PG8_STAGE(PG8_SA(1, 1), a1 + hstepA, voffA);
            PG8_WAIT_L(8); PG8_BAR; PG8_WAIT_L(0); PG8_MMA(0, 0, At, B0); PG8_BAR; PG8_SCHED;
            PG8_LDB(B1, 0, 1); PG8_STAGE(PG8_SB(0, 0), b2, voffB);
            PG8_BAR; PG8_WAIT_L(0); PG8_MMA(0, 1, At, B1); PG8_BAR;
            PG8_LDA(At, 0, 1); PG8_STAGE(PG8_SA(0, 0), a2, voffA);
            PG8_BAR; PG8_WAIT_L(0); PG8_MMA(1, 0, At, B0); PG8_BAR; PG8_SCHED;
            PG8_STAGE(PG8_SB(0, 1), b2 + hstep, voffB);
            PG8_WAIT_V(6); PG8_BAR; PG8_MMA(1, 1, At, B1); PG8_BAR;
            PG8_LDB(B0, 1, 0); PG8_SCHED; PG8_LDA(At, 1, 0); PG8_STAGE(PG8_SA(0, 1), a2 + hstepA, voffA);
            PG8_WAIT_L(8); PG8_BAR; PG8_WAIT_L(0); PG8_MMA(0, 0, At, B0); PG8_BAR; PG8_SCHED;
            PG8_LDB(B1, 1, 1); PG8_STAGE(PG8_SB(1, 0), b3, voffB);
            PG8_BAR; PG8_WAIT_L(0); PG8_MMA(0, 1, At, B1); PG8_BAR;
            PG8_LDA(At, 1, 1); PG8_STAGE(PG8_SA(1, 0), a3, voffA);
            PG8_BAR; PG8_WAIT_L(0); PG8_MMA(1, 0, At, B0); PG8_BAR; PG8_SCHED;
            PG8_STAGE(PG8_SB(1, 1), b3 + hstep, voffB);
            PG8_WAIT_V(6); PG8_BAR; PG8_MMA(1, 1, At, B1); PG8_BAR;
            }
        }
        if constexpr (ALIGN_EPI) { if (wr == 0) PG8_BAR; }
        if constexpr (!Epi::AFTER_DRAIN) { E(acc, cur, wr, wc, fr, fq); S.done(cur); }
        if (!has_next) break;
#pragma unroll
        for (int a = 0; a < 2; ++a)
#pragma unroll
            for (int b = 0; b < 2; ++b)
#pragma unroll
                for (int m = 0; m < 4; ++m)
#pragma unroll
                    for (int n = 0; n < 2; ++n) acc[a][b][m][n] = (f32x4){0.f, 0.f, 0.f, 0.f};
        cur = nxt; cA = nA; cB = nB; ++ui;
        if constexpr (ALIGN_EPI) { if (wr == 1) PG8_BAR; }
    }
    PG8_WAIT_V(0);
    if constexpr (!ALIGN_EPI) { if (wr == 0) PG8_BAR; }
    PG8_BAR;
    if constexpr (Epi::AFTER_DRAIN) { E.fused(acc, cur, wr, wc, fr, fq, lds, wid, lane); S.done(cur); }
#undef PG8_SA
#undef PG8_SB
#undef PG8_STAGE
#undef PG8_LDA
#undef PG8_LDB
#undef PG8_MMA
#undef PG8_WAIT_V
#undef PG8_WAIT_L
#undef PG8_BAR
#undef PG8_SCHED
}
}
namespace att {
typedef unsigned short bf16_t;
typedef short bf16x8 __attribute__((ext_vector_type(8)));
typedef short s16x4 __attribute__((ext_vector_type(4)));
typedef float f32x16 __attribute__((ext_vector_type(16)));
typedef unsigned u32x4 __attribute__((ext_vector_type(4)));
constexpr int D = 128, NW = 8, QBLK = 32, KVBLK = 64;
constexpr float SCALE = 0.088388347648318440f;
constexpr float THR = 8.f;
constexpr int NBUF = 3;
constexpr size_t SHM_V = KVBLK * D * 2, SHM_K = KVBLK * D * 2, SHM_ATTN = NBUF * SHM_V + NBUF * SHM_K + NW * 64 * 4;
#define ATT_KSWZ(row, colB) ((row) * 256 + ((colB) ^ (((row) & 7) << 4)))
#define ATT_SBAR() __builtin_amdgcn_sched_barrier(0)
__device__ __forceinline__ int crow(int r, int hi) { return (r & 3) + 8 * (r >> 2) + 4 * hi; }
__device__ __forceinline__ unsigned cvtpk(float lo, float hi) { unsigned r; asm volatile("v_cvt_pk_bf16_f32 %0, %1, %2" : "=v"(r) : "v"(lo), "v"(hi)); return r; }
__device__ __forceinline__ bf16x8 ld8(const bf16_t* p) { return *reinterpret_cast<const bf16x8*>(p); }

constexpr bool NOMAX = true;
__device__ __forceinline__ void partialSM(f32x16& p0, f32x16& p1, float& m_reg, float& mn, float& alpha) {
  constexpr float C = SCALE * 1.4426950408889634f;
  if (NOMAX) { alpha = 1.f; mn = m_reg; const float mC = -m_reg * C;
    __builtin_amdgcn_sched_barrier(0);
#pragma unroll
    for (int r = 0; r < 16; ++r) p0[r] = fmaf(p0[r], C, mC);
#pragma unroll
    for (int r = 0; r < 16; ++r) p1[r] = fmaf(p1[r], C, mC);
#pragma unroll
    for (int r = 0; r < 16; ++r) p0[r] = __builtin_amdgcn_exp2f(p0[r]);
    return; }
  float pmax = p0[0];
#pragma unroll
  for (int r = 1; r < 16; ++r) pmax = fmaxf(pmax, p0[r]);
#pragma unroll
  for (int r = 0; r < 16; ++r) pmax = fmaxf(pmax, p1[r]);
  { auto rr = __builtin_amdgcn_permlane32_swap(__float_as_uint(pmax), __float_as_uint(pmax), false, false);
    pmax = fmaxf(__uint_as_float(rr[0]), __uint_as_float(rr[1])); }
  if (__builtin_expect(__all(pmax - m_reg <= THR / SCALE), 1)) { mn = m_reg; alpha = 1.f; }
  else { mn = fmaxf(m_reg, pmax); alpha = __builtin_amdgcn_exp2f((m_reg - mn) * C); m_reg = mn; }
  float mnC = -mn * C;
#pragma unroll
  for (int r = 0; r < 16; ++r) p0[r] = fmaf(p0[r], C, mnC);
#pragma unroll
  for (int r = 0; r < 16; ++r) p1[r] = fmaf(p1[r], C, mnC);
#pragma unroll
  for (int r = 0; r < 16; ++r) p0[r] = __builtin_amdgcn_exp2f(p0[r]);
}
__device__ __forceinline__ void finishSM(f32x16& p0, f32x16& p1, float alpha, float& l_reg, bf16x8& pa0, bf16x8& pa1, bf16x8& pa2, bf16x8& pa3) {
#pragma unroll
  for (int r = 0; r < 16; ++r) p1[r] = __builtin_amdgcn_exp2f(p1[r]);
  float ps = 0;
#pragma unroll
  for (int r = 0; r < 16; ++r) ps += p0[r];
#pragma unroll
  for (int r = 0; r < 16; ++r) ps += p1[r];
  { auto rr = __builtin_amdgcn_permlane32_swap(__float_as_uint(ps), __float_as_uint(ps), false, false);
    ps = __uint_as_float(rr[0]) + __uint_as_float(rr[1]); }
  l_reg = l_reg * alpha + ps;
#define ATT_PK4(P, BASE, OUT) do { unsigned a0 = cvtpk(P[BASE + 0], P[BASE + 1]), a1 = cvtpk(P[BASE + 2], P[BASE + 3]);   \
    unsigned b0 = cvtpk(P[BASE + 4], P[BASE + 5]), b1 = cvtpk(P[BASE + 6], P[BASE + 7]);                              \
    auto r0 = __builtin_amdgcn_permlane32_swap(a0, b0, false, false); auto r1 = __builtin_amdgcn_permlane32_swap(a1, b1, false, false); \
    u32x4 w = {r0[0], r1[0], r0[1], r1[1]}; OUT = *reinterpret_cast<bf16x8*>(&w); } while (0)
  ATT_PK4(p0, 0, pa0); ATT_PK4(p0, 8, pa1); ATT_PK4(p1, 0, pa2); ATT_PK4(p1, 8, pa3);
#undef ATT_PK4
}
__device__ __forceinline__ void qkt(f32x16& p0, f32x16& p1, const bf16_t* Ks, const bf16x8* qr, int r32, int hi) {
  p0 = f32x16{}; p1 = f32x16{};
#pragma unroll
  for (int d0 = 0; d0 < 8; ++d0) { int cb = (d0 * 16 + hi * 8) * 2;
    bf16x8 b0 = *reinterpret_cast<const bf16x8*>((const char*)Ks + ATT_KSWZ(r32, cb));
    bf16x8 b1 = *reinterpret_cast<const bf16x8*>((const char*)Ks + ATT_KSWZ(32 + r32, cb));
    p0 = __builtin_amdgcn_mfma_f32_32x32x16_bf16(b0, qr[d0], p0, 0, 0, 0);
    p1 = __builtin_amdgcn_mfma_f32_32x32x16_bf16(b1, qr[d0], p1, 0, 0, 0); }
}
__device__ __forceinline__ void band_mask(f32x16& p0, f32x16& p1, int qpos, int kbase, int hi) {
#pragma unroll
  for (int r = 0; r < 16; ++r) { const int d = kbase + crow(r, hi) - qpos;
    if ((unsigned)(d + 128) > 256u) p0[r] = -1e30f;
    if ((unsigned)(d + 160) > 256u) p1[r] = -1e30f; }
}
__device__ __forceinline__ int v_st(int k, int c) { const int kk = (k & ~0xC) | ((k & 4) << 1) | ((k & 8) >> 1); return ((kk >> 3) * 4 + (c >> 5)) * 512 + ((kk & 7) * 32 + (c & 31)) * 2; }
__device__ __forceinline__ int v_rd_base(int lane) { return ((lane & 3) << 3) | (((lane >> 2) & 3) << 6) | (((lane >> 4) & 1) << 5) | (((lane >> 5) & 1) << 8); }
constexpr int v_rd_off(int d0, int ks, int half) { return d0 * 512 + ks * 4096 + half * 2048; }
template <int OFF> __device__ __forceinline__ s16x4 tr_read(int vb) {
  s16x4 r; asm volatile("ds_read_b64_tr_b16 %0, %1 offset:%2" : "=&v"(r) : "v"(vb), "i"(OFF) : "memory"); return r;
}
template <int D0> __device__ __forceinline__ void pv_one(f32x16& od, int vb, bf16x8 pa0, bf16x8 pa1, bf16x8 pa2, bf16x8 pa3) {
  const s16x4 l0 = tr_read<v_rd_off(D0, 0, 0)>(vb), h0 = tr_read<v_rd_off(D0, 0, 1)>(vb), l1 = tr_read<v_rd_off(D0, 1, 0)>(vb), h1 = tr_read<v_rd_off(D0, 1, 1)>(vb);
  const s16x4 l2 = tr_read<v_rd_off(D0, 2, 0)>(vb), h2 = tr_read<v_rd_off(D0, 2, 1)>(vb), l3 = tr_read<v_rd_off(D0, 3, 0)>(vb), h3 = tr_read<v_rd_off(D0, 3, 1)>(vb);
  asm volatile("s_waitcnt lgkmcnt(0)" ::: "memory"); ATT_SBAR();
#define ATT_PK(L, H) (bf16x8){L[0], L[1], L[2], L[3], H[0], H[1], H[2], H[3]}
  od = __builtin_amdgcn_mfma_f32_32x32x16_bf16(pa0, ATT_PK(l0, h0), od, 0, 0, 0);
  od = __builtin_amdgcn_mfma_f32_32x32x16_bf16(pa1, ATT_PK(l1, h1), od, 0, 0, 0);
  od = __builtin_amdgcn_mfma_f32_32x32x16_bf16(pa2, ATT_PK(l2, h2), od, 0, 0, 0);
  od = __builtin_amdgcn_mfma_f32_32x32x16_bf16(pa3, ATT_PK(l3, h3), od, 0, 0, 0);
#undef ATT_PK
}
__device__ __forceinline__ void pv_d0(f32x16* o, int vb, bf16x8 pa0, bf16x8 pa1, bf16x8 pa2, bf16x8 pa3) {
  pv_one<0>(o[0], vb, pa0, pa1, pa2, pa3); pv_one<1>(o[1], vb, pa0, pa1, pa2, pa3); pv_one<2>(o[2], vb, pa0, pa1, pa2, pa3); pv_one<3>(o[3], vb, pa0, pa1, pa2, pa3);
}

struct Unit {
  const bf16_t* Q; int ldq;
  const bf16_t* K0; const bf16_t* V0; int ld0, n0;
  const bf16_t* K1; const bf16_t* V1; int ld1, n1;
  int mask, qpos0, kpos0;
  float m_init, l_init;
  bf16_t* O; int ldo;
};

__device__ __forceinline__ void attn_unit(const Unit& U, char* lds, const int wave_id) {
  int tid_ = (wave_id << 6) | (int)__builtin_amdgcn_mbcnt_hi(~0u, __builtin_amdgcn_mbcnt_lo(~0u, 0u)); asm volatile("" : "+v"(tid_));
  const int tid = tid_, wid = tid >> 6, lane = tid & 63, r32 = lane & 31, hi = lane >> 5;
  bf16_t* V_lds = (bf16_t*)lds; bf16_t* K_lds = (bf16_t*)(lds + NBUF * SHM_V);
  float* ws = (float*)(lds + NBUF * SHM_V + NBUF * SHM_K) + wid * 64; float* li_l = ws; float* al_l = ws + 32;
  float m_reg = U.m_init, l_reg = U.l_init; f32x16 o[4] = {}; bf16x8 qr[8];
  const bf16_t* Qw = U.Q + (long)(wid * QBLK + r32) * U.ldq + hi * 8;
#pragma unroll
  for (int d0 = 0; d0 < 8; ++d0) qr[d0] = ld8(Qw + d0 * 16);
  typedef const __attribute__((address_space(1))) bf16_t* gbf;
  __attribute__((address_space(3))) char* const ldsl = (__attribute__((address_space(3))) char*)lds;
  int rK0, rK1, cK0, cK1, rV0, rV1, cV0, cV1;
  { const int r0_ = 4 * (2 * wave_id) + (lane >> 4), r1_ = r0_ + 4; rK0 = r0_; rK1 = r1_; cK0 = ((lane & 15) ^ (r0_ & 7)) * 8; cK1 = ((lane & 15) ^ (r1_ & 7)) * 8;
    const int q0_ = 64 * (2 * wave_id) + lane, q1_ = q0_ + 64;
    { const int s_ = q0_ >> 5, t_ = q0_ & 31, kk_ = (s_ >> 2) * 8 + (t_ >> 2); rV0 = (kk_ & ~0xC) | ((kk_ & 4) << 1) | ((kk_ & 8) >> 1); cV0 = (s_ & 3) * 32 + (t_ & 3) * 8; }
    { const int s_ = q1_ >> 5, t_ = q1_ & 31, kk_ = (s_ >> 2) * 8 + (t_ >> 2); rV1 = (kk_ & ~0xC) | ((kk_ & 4) << 1) | ((kk_ & 8) >> 1); cV1 = (s_ & 3) * 32 + (t_ & 3) * 8; } }
  const int vb0 = (int)(uintptr_t)V_lds + v_rd_base(lane);
  const int qpos = U.qpos0 + wid * QBLK + r32, qlo = U.qpos0 + wid * QBLK;
#define ATT_STAGE(t, b) do { const int t_ = (t); gbf kp_; gbf vp_; long ld_;                                                             \
    if (t_ < U.n0) { ld_ = U.ld0; kp_ = (gbf)U.K0 + (long)t_ * KVBLK * ld_; vp_ = (gbf)U.V0 + (long)t_ * KVBLK * ld_; }                 \
    else { ld_ = U.ld1; kp_ = (gbf)U.K1 + (long)(t_ - U.n0) * KVBLK * ld_; vp_ = (gbf)U.V1 + (long)(t_ - U.n0) * KVBLK * ld_; }           \
    __attribute__((address_space(3))) char* kd_ = ldsl + NBUF * SHM_V + (b) * SHM_K + wave_id * 2048;                                    \
    __attribute__((address_space(3))) char* vd_ = ldsl + (b) * SHM_V + wave_id * 2048;                                                   \
    __builtin_amdgcn_global_load_lds((const __attribute__((address_space(1))) unsigned*)(kp_ + (long)rK0 * ld_ + cK0), (__attribute__((address_space(3))) unsigned*)kd_, 16, 0, 0);          \
    __builtin_amdgcn_global_load_lds((const __attribute__((address_space(1))) unsigned*)(kp_ + (long)rK1 * ld_ + cK1), (__attribute__((address_space(3))) unsigned*)(kd_ + 1024), 16, 0, 0);  \
    __builtin_amdgcn_global_load_lds((const __attribute__((address_space(1))) unsigned*)(vp_ + (long)rV0 * ld_ + cV0), (__attribute__((address_space(3))) unsigned*)vd_, 16, 0, 0);          \
    __builtin_amdgcn_global_load_lds((const __attribute__((address_space(1))) unsigned*)(vp_ + (long)rV1 * ld_ + cV1), (__attribute__((address_space(3))) unsigned*)(vd_ + 1024), 16, 0, 0); } while (0)
#define ATT_RESC(a) do { if (!NOMAX && __any((a) < 1.f)) { if (hi == 0) al_l[r32] = (a); asm volatile("s_waitcnt lgkmcnt(0)" ::: "memory"); \
    _Pragma("unroll") for (int d = 0; d < 4; ++d) _Pragma("unroll") for (int r = 0; r < 16; ++r) o[d][r] *= al_l[crow(r, hi)]; } } while (0)
#define ATT_MASK(P0, P1, t) do { const int t_ = (t); if (U.mask && t_ < U.n0) { const int kb_ = U.kpos0 + t_ * KVBLK;                  \
    if (kb_ + 63 - qlo > 128 || qlo + 31 - kb_ > 128) band_mask(P0, P1, qpos, kb_, hi); } } while (0)
  f32x16 pA0, pA1, pB0, pB1; float mnA, mnB, alA, alB; bf16x8 pa0, pa1, pa2, pa3; const int NT = U.n0 + U.n1, TL = NT - 1;
#define ATT_BAR() do { asm volatile("s_waitcnt lgkmcnt(0)" ::: "memory"); __builtin_amdgcn_s_barrier(); asm volatile("" ::: "memory"); } while (0)
#define ATT_HALF(P0, P1, MN, AL, Q0, Q1, MNQ, ALQ, jj) do {                                                                                \
    const int bn_ = (bcur == 2) ? 0 : bcur + 1;                                                                                            \
    ATT_SBAR(); qkt(Q0, Q1, (bf16_t*)((char*)K_lds + bn_ * SHM_K), qr, r32, hi);                                                          \
    finishSM(P0, P1, AL, l_reg, pa0, pa1, pa2, pa3); ATT_SBAR();                                                                           \
    pv_d0(o, vb0 + bcur * (int)SHM_V, pa0, pa1, pa2, pa3); ATT_MASK(Q0, Q1, (jj) + 1); partialSM(Q0, Q1, m_reg, MNQ, ALQ);                  \
    ATT_BAR();                                                                                                                             \
    if ((jj) + 3 < NT) { ATT_STAGE((jj) + 3, bcur); asm volatile("s_waitcnt vmcnt(4)" ::: "memory"); } else asm volatile("s_waitcnt vmcnt(0)" ::: "memory");  \
    ATT_RESC(ALQ); ATT_BAR();                                                                                                              \
    bcur = bn_; } while (0)
  ATT_STAGE(0, 0); ATT_STAGE(1, 1); ATT_STAGE(2, 2); asm volatile("s_waitcnt vmcnt(4)" ::: "memory"); ATT_BAR();
  qkt(pA0, pA1, K_lds, qr, r32, hi); ATT_MASK(pA0, pA1, 0); partialSM(pA0, pA1, m_reg, mnA, alA);
  int bcur = 0;
  for (int j = 0; j + 2 < NT; j += 2) {
    ATT_HALF(pA0, pA1, mnA, alA, pB0, pB1, mnB, alB, j);
    ATT_HALF(pB0, pB1, mnB, alB, pA0, pA1, mnA, alA, j + 1);
  }
  ATT_HALF(pA0, pA1, mnA, alA, pB0, pB1, mnB, alB, NT - 2);
  finishSM(pB0, pB1, alB, l_reg, pa0, pa1, pa2, pa3); ATT_SBAR();
  pv_d0(o, vb0 + bcur * (int)SHM_V, pa0, pa1, pa2, pa3);
#undef ATT_HALF
  if (hi == 0) li_l[r32] = l_reg; asm volatile("s_waitcnt lgkmcnt(0)" ::: "memory");
  float rli[16];
#pragma unroll
  for (int r = 0; r < 16; ++r) rli[r] = __builtin_amdgcn_rcpf(li_l[crow(r, hi)]);
  bf16_t* Ow = U.O + (long)(wid * QBLK) * U.ldo;
#pragma unroll
  for (int r = 0; r < 16; ++r) { const int orow = crow(r, hi);
#pragma unroll
    for (int d0 = 0; d0 < 4; d0 += 2) { const unsigned w = cvtpk(o[d0][r] * rli[r], o[d0 + 1][r] * rli[r]);
      Ow[(long)orow * U.ldo + d0 * 32 + r32] = (bf16_t)(w & 0xffffu); Ow[(long)orow * U.ldo + (d0 + 1) * 32 + r32] = (bf16_t)(w >> 16); } }
  asm volatile("s_waitcnt vmcnt(0)" ::: "memory"); ATT_BAR();
#undef ATT_BAR
#undef ATT_STAGE
#undef ATT_RESC
#undef ATT_MASK
}

constexpr int B_SHM_K = 64 * 128 * 2, B_SHM_V = 64 * 256 * 2, B_SHM_F = 8 * 2 * 64 * 16;
constexpr int B_OFF_K = 0, B_OFF_V = 2 * B_SHM_K, B_OFF_F = B_OFF_V + 2 * B_SHM_V, B_SHM_TOTAL = B_OFF_F + 2 * B_SHM_F;
struct UnitB {
  const bf16_t* Q; int ldq;
  const bf16_t* K0; const bf16_t* V0; int ld0, n0;
  const bf16_t* K1; const bf16_t* V1; int ld1, n1;
  float m_bound;
  bf16_t* O; int ldo;
  const float* subln; float lam, osc;
};
constexpr int vb_rd_off(int dd, int ks, int half) { return dd * 512 + ks * 8192 + half * 4096; }
template <int DD> __device__ __forceinline__ void pv_oneB(f32x16& od, int vb, bf16x8 pa0, bf16x8 pa1, bf16x8 pa2, bf16x8 pa3) {
  const s16x4 l0 = tr_read<vb_rd_off(DD, 0, 0)>(vb), h0 = tr_read<vb_rd_off(DD, 0, 1)>(vb), l1 = tr_read<vb_rd_off(DD, 1, 0)>(vb), h1 = tr_read<vb_rd_off(DD, 1, 1)>(vb);
  const s16x4 l2 = tr_read<vb_rd_off(DD, 2, 0)>(vb), h2 = tr_read<vb_rd_off(DD, 2, 1)>(vb), l3 = tr_read<vb_rd_off(DD, 3, 0)>(vb), h3 = tr_read<vb_rd_off(DD, 3, 1)>(vb);
  asm volatile("s_waitcnt lgkmcnt(0)" ::: "memory"); ATT_SBAR();
#define ATT_PK(L, H) (bf16x8){L[0], L[1], L[2], L[3], H[0], H[1], H[2], H[3]}
  od = __builtin_amdgcn_mfma_f32_32x32x16_bf16(pa0, ATT_PK(l0, h0), od, 0, 0, 0);
  od = __builtin_amdgcn_mfma_f32_32x32x16_bf16(pa1, ATT_PK(l1, h1), od, 0, 0, 0);
  od = __builtin_amdgcn_mfma_f32_32x32x16_bf16(pa2, ATT_PK(l2, h2), od, 0, 0, 0);
  od = __builtin_amdgcn_mfma_f32_32x32x16_bf16(pa3, ATT_PK(l3, h3), od, 0, 0, 0);
#undef ATT_PK
}
template <int DD> __device__ __forceinline__ void pv_issueB(s16x4 (&G)[8], int vb) {
  G[0] = tr_read<vb_rd_off(DD, 0, 0)>(vb); G[1] = tr_read<vb_rd_off(DD, 0, 1)>(vb); G[2] = tr_read<vb_rd_off(DD, 1, 0)>(vb); G[3] = tr_read<vb_rd_off(DD, 1, 1)>(vb);
  G[4] = tr_read<vb_rd_off(DD, 2, 0)>(vb); G[5] = tr_read<vb_rd_off(DD, 2, 1)>(vb); G[6] = tr_read<vb_rd_off(DD, 3, 0)>(vb); G[7] = tr_read<vb_rd_off(DD, 3, 1)>(vb);
}
__device__ __forceinline__ void pv_mmaB(f32x16& od, const s16x4 (&G)[8], bf16x8 pa0, bf16x8 pa1, bf16x8 pa2, bf16x8 pa3) {
#define ATT_PK(L, H) (bf16x8){L[0], L[1], L[2], L[3], H[0], H[1], H[2], H[3]}
  __builtin_amdgcn_s_setprio(1);
  od = __builtin_amdgcn_mfma_f32_32x32x16_bf16(pa0, ATT_PK(G[0], G[1]), od, 0, 0, 0);
  od = __builtin_amdgcn_mfma_f32_32x32x16_bf16(pa1, ATT_PK(G[2], G[3]), od, 0, 0, 0);
  od = __builtin_amdgcn_mfma_f32_32x32x16_bf16(pa2, ATT_PK(G[4], G[5]), od, 0, 0, 0);
  od = __builtin_amdgcn_mfma_f32_32x32x16_bf16(pa3, ATT_PK(G[6], G[7]), od, 0, 0, 0);
  __builtin_amdgcn_s_setprio(0);
#undef ATT_PK
}
template <int C_> __device__ __forceinline__ void attb_pass(const UnitB& U, char* lds, const int wave_id, unsigned (&P0pk)[32]) {
  int tid_ = (wave_id << 6) | (int)__builtin_amdgcn_mbcnt_hi(~0u, __builtin_amdgcn_mbcnt_lo(~0u, 0u)); asm volatile("" : "+v"(tid_));
  const int tid = tid_, wid = wave_id, lane = tid & 63, r32 = lane & 31, hi = lane >> 5, rg = wid & 3, x = wid >> 2;
  char* K_lds = lds + B_OFF_K; char* V_lds = lds + B_OFF_V; char* F_lds = lds + B_OFF_F;
  constexpr float C = SCALE * 1.4426950408889634f;
  const float mC = -U.m_bound * C;
  const int srk = tid >> 4, sck = (tid & 15) * 8, srv = tid >> 5, scv = (tid & 31) * 8;
  const int kst0 = ATT_KSWZ(srk, sck * 2), kst1 = ATT_KSWZ(32 + srk, sck * 2);
  int vst0; { const int kk = (srv & ~0xC) | ((srv & 4) << 1) | ((srv & 8) >> 1); vst0 = ((kk >> 3) * 8 + (scv >> 5)) * 512 + ((kk & 7) * 32 + (scv & 31)) * 2; }
  const int vb0 = (int)(uintptr_t)V_lds + x * 2048 + v_rd_base(lane);
  char* const fw = F_lds + (wid * 2) * 1024 + lane * 16;
  const char* const fr_ = F_lds + (rg * 2) * 1024 + lane * 16;
  typedef const __attribute__((address_space(1))) bf16_t* gbf; typedef const __attribute__((address_space(1))) bf16x8* gbf8;
#define B_TILE(t, KP, VP, LD) gbf KP; gbf VP; long LD; { const int t_ = (t);                                                           \
    if (t_ < U.n0) { LD = U.ld0; KP = (gbf)U.K0 + coff + (long)t_ * KVBLK * LD; VP = (gbf)U.V0 + (long)t_ * KVBLK * LD; }              \
    else { LD = U.ld1; KP = (gbf)U.K1 + coff + (long)(t_ - U.n0) * KVBLK * LD; VP = (gbf)U.V1 + (long)(t_ - U.n0) * KVBLK * LD; } }
#define B_LD8(p) (*(gbf8)(p))
  __attribute__((address_space(3))) char* const ldsl = (__attribute__((address_space(3))) char*)lds;
  int rK0, rK1, cK0, cK1, rV[4], cV[4];
  { const int r0_ = 4 * (2 * wave_id) + (lane >> 4), r1_ = r0_ + 4; rK0 = r0_; rK1 = r1_; cK0 = ((lane & 15) ^ (r0_ & 7)) * 8; cK1 = ((lane & 15) ^ (r1_ & 7)) * 8;
#pragma unroll
    for (int i = 0; i < 4; ++i) { const int q_ = 64 * (4 * wave_id + i) + lane, s_ = q_ >> 5, t_ = q_ & 31, kk_ = (s_ >> 3) * 8 + (t_ >> 2);
      rV[i] = (kk_ & ~0xC) | ((kk_ & 4) << 1) | ((kk_ & 8) >> 1); cV[i] = (s_ & 7) * 32 + (t_ & 3) * 8; } }
#define B_DMAK(t, b) do { B_TILE(t, kp_, vp_, ld_); (void)vp_;                                                                             \
    __attribute__((address_space(3))) char* kd_ = ldsl + B_OFF_K + (b) * B_SHM_K + wave_id * 2048;                                          \
    __builtin_amdgcn_global_load_lds((const __attribute__((address_space(1))) unsigned*)(kp_ + (long)rK0 * ld_ + cK0), (__attribute__((address_space(3))) unsigned*)kd_, 16, 0, 0);          \
    __builtin_amdgcn_global_load_lds((const __attribute__((address_space(1))) unsigned*)(kp_ + (long)rK1 * ld_ + cK1), (__attribute__((address_space(3))) unsigned*)(kd_ + 1024), 16, 0, 0); } while (0)
#define B_DMAV(t, b) do { B_TILE(t, kp_, vp_, ld_); (void)kp_;                                                                             \
    __attribute__((address_space(3))) char* vd_ = ldsl + B_OFF_V + (b) * B_SHM_V + wave_id * 4096;                                          \
    _Pragma("unroll") for (int i_ = 0; i_ < 4; ++i_)                                                                                       \
      __builtin_amdgcn_global_load_lds((const __attribute__((address_space(1))) unsigned*)(vp_ + (long)rV[i_] * ld_ + cV[i_]), (__attribute__((address_space(3))) unsigned*)(vd_ + i_ * 1024), 16, 0, 0); } while (0)
#define B_END() do { asm volatile("s_waitcnt vmcnt(0)" ::: "memory"); __syncthreads(); } while (0)
#define B_LOADK(R, t) do { B_TILE(t, kp_, vp_, ld_); (void)vp_; R.k0 = B_LD8(kp_ + (long)srk * ld_ + sck); R.k1 = B_LD8(kp_ + (long)(32 + srk) * ld_ + sck); } while (0)
#define B_LOADV(R, t) do { B_TILE(t, kp_, vp_, ld_); (void)kp_; R.v0 = B_LD8(vp_ + (long)srv * ld_ + scv); R.v1 = B_LD8(vp_ + (long)(16 + srv) * ld_ + scv);     \
    R.v2 = B_LD8(vp_ + (long)(32 + srv) * ld_ + scv); R.v3 = B_LD8(vp_ + (long)(48 + srv) * ld_ + scv); } while (0)
#define B_WRITEK(b, R) do { *(bf16x8*)(K_lds + (b) * B_SHM_K + kst0) = R.k0; *(bf16x8*)(K_lds + (b) * B_SHM_K + kst1) = R.k1; } while (0)
#define B_WRITEV(b, R) do { *(bf16x8*)(V_lds + (b) * B_SHM_V + vst0) = R.v0; *(bf16x8*)(V_lds + (b) * B_SHM_V + vst0 + 8192) = R.v1;        \
    *(bf16x8*)(V_lds + (b) * B_SHM_V + vst0 + 16384) = R.v2; *(bf16x8*)(V_lds + (b) * B_SHM_V + vst0 + 24576) = R.v3; } while (0)
#define B_QK(b) do { bf16x8 kf[4];                                                                                                        \
    _Pragma("unroll") for (int d0 = 0; d0 < 4; ++d0) kf[d0] = *reinterpret_cast<const bf16x8*>(K_lds + (b) * B_SHM_K + ATT_KSWZ(32 * x + r32, (d0 * 16 + hi * 8) * 2)); \
    pS = f32x16{};                                                                                                                         \
    _Pragma("unroll") for (int d0 = 0; d0 < 8; ++d0) { pS = __builtin_amdgcn_mfma_f32_32x32x16_bf16(kf[d0 & 3], qr[d0], pS, 0, 0, 0);          \
      if (d0 + 4 < 8) kf[d0 & 3] = *reinterpret_cast<const bf16x8*>(K_lds + (b) * B_SHM_K + ATT_KSWZ(32 * x + r32, ((d0 + 4) * 16 + hi * 8) * 2)); } } while (0)
#define B_SM_EXP(lo) do { _Pragma("unroll") for (int r = (lo); r < (lo) + 8; r += 2) { const f32x2p t_ = (f32x2p){pS[r], pS[r + 1]} * C + mC2;     \
      pS[r] = __builtin_amdgcn_exp2f(t_[0]); pS[r + 1] = __builtin_amdgcn_exp2f(t_[1]); } } while (0)
#define B_SM_PUB(b) do { _Pragma("unroll") for (int r = 0; r < 16; r += 2) l2 += (f32x2p){pS[r], pS[r + 1]};                                     \
    bf16x8 fa, fb;                                                                                                                        \
    { unsigned a0 = cvtpk(pS[0], pS[1]), a1 = cvtpk(pS[2], pS[3]), b0 = cvtpk(pS[4], pS[5]), b1 = cvtpk(pS[6], pS[7]);                      \
      auto r0 = __builtin_amdgcn_permlane32_swap(a0, b0, false, false); auto r1 = __builtin_amdgcn_permlane32_swap(a1, b1, false, false);   \
      u32x4 w = {r0[0], r1[0], r0[1], r1[1]}; fa = *reinterpret_cast<bf16x8*>(&w); }                                                       \
    { unsigned a0 = cvtpk(pS[8], pS[9]), a1 = cvtpk(pS[10], pS[11]), b0 = cvtpk(pS[12], pS[13]), b1 = cvtpk(pS[14], pS[15]);                \
      auto r0 = __builtin_amdgcn_permlane32_swap(a0, b0, false, false); auto r1 = __builtin_amdgcn_permlane32_swap(a1, b1, false, false);   \
      u32x4 w = {r0[0], r1[0], r0[1], r1[1]}; fb = *reinterpret_cast<bf16x8*>(&w); }                                                       \
    *(bf16x8*)(fw + (b) * B_SHM_F) = fa; *(bf16x8*)(fw + (b) * B_SHM_F + 1024) = fb; } while (0)
#define B_PV_SM(bp, b) do {                                                                                                               \
    const bf16x8 pa0 = *(const bf16x8*)(fr_ + (bp) * B_SHM_F), pa1 = *(const bf16x8*)(fr_ + (bp) * B_SHM_F + 1024);                         \
    const bf16x8 pa2 = *(const bf16x8*)(fr_ + (bp) * B_SHM_F + 8192), pa3 = *(const bf16x8*)(fr_ + (bp) * B_SHM_F + 8192 + 1024);           \
    s16x4 G0[8], G1[8]; const int vb_ = vb0 + (bp) * B_SHM_V;                                                                               \
    ATT_SBAR(); pv_issueB<0>(G0, vb_); pv_issueB<1>(G1, vb_);                         \
    asm volatile("s_waitcnt lgkmcnt(8)" ::: "memory"); ATT_SBAR();                                 \
    pv_mmaB(o[0], G0, pa0, pa1, pa2, pa3); ATT_SBAR(); B_SM_EXP(0); pv_issueB<2>(G0, vb_);                                                   \
    asm volatile("s_waitcnt lgkmcnt(8)" ::: "memory"); ATT_SBAR();                                                                 \
    pv_mmaB(o[1], G1, pa0, pa1, pa2, pa3); ATT_SBAR(); B_SM_EXP(8); pv_issueB<3>(G1, vb_);                                                   \
    asm volatile("s_waitcnt lgkmcnt(8)" ::: "memory"); ATT_SBAR();                                                                 \
    pv_mmaB(o[2], G0, pa0, pa1, pa2, pa3); ATT_SBAR(); B_SM_PUB(b);                                                                          \
    asm volatile("s_waitcnt lgkmcnt(0)" ::: "memory"); ATT_SBAR();                                   \
    pv_mmaB(o[3], G1, pa0, pa1, pa2, pa3); } while (0)
#define B_PV(bp) do {                                                                                                                     \
    const bf16x8 pa0 = *(const bf16x8*)(fr_ + (bp) * B_SHM_F), pa1 = *(const bf16x8*)(fr_ + (bp) * B_SHM_F + 1024);                         \
    const bf16x8 pa2 = *(const bf16x8*)(fr_ + (bp) * B_SHM_F + 8192), pa3 = *(const bf16x8*)(fr_ + (bp) * B_SHM_F + 8192 + 1024);           \
    pv_oneB<0>(o[0], vb0 + (bp) * B_SHM_V, pa0, pa1, pa2, pa3); pv_oneB<1>(o[1], vb0 + (bp) * B_SHM_V, pa0, pa1, pa2, pa3);                 \
    pv_oneB<2>(o[2], vb0 + (bp) * B_SHM_V, pa0, pa1, pa2, pa3); pv_oneB<3>(o[3], vb0 + (bp) * B_SHM_V, pa0, pa1, pa2, pa3); } while (0)
  f32x16 pS;
  const int NT = U.n0 + U.n1;
  constexpr int c = C_; constexpr int coff = C_ * 128;
  typedef float f32x2p __attribute__((ext_vector_type(2)));
  f32x2p l2 = {0.f, 0.f}; const f32x2p mC2 = {mC, mC}; f32x16 o[4] = {}; bf16x8 qr[8];
  { const bf16_t* Qw = U.Q + coff + (long)(rg * QBLK + r32) * U.ldq + hi * 8;
#pragma unroll
    for (int d0 = 0; d0 < 8; ++d0) qr[d0] = ld8(Qw + d0 * 16); }
  B_DMAK(0, 0); B_END();
  B_DMAK(1, 1); B_DMAV(0, 0);
  B_QK(0); B_SM_EXP(0); B_SM_EXP(8); B_SM_PUB(0);
  B_END();
  for (int t = 1; t + 1 < NT; t += 2) {
    B_DMAK(t + 1, 0); B_DMAV(t, 1);
    ATT_SBAR(); B_QK(1); ATT_SBAR();
    B_PV_SM(0, 1);
    B_END();
    if (t + 2 < NT) B_DMAK(t + 2, 1);
    B_DMAV(t + 1, 0);
    ATT_SBAR(); B_QK(0); ATT_SBAR();
    B_PV_SM(1, 0);
    B_END();
  }
  B_DMAV(NT - 1, 1);
  ATT_SBAR(); B_QK(1); ATT_SBAR();
  B_PV_SM(0, 1);
  B_END();
  B_PV(1);
  __syncthreads();
  float* L = (float*)F_lds;
  { const float l_reg = l2[0] + l2[1];
    auto rr = __builtin_amdgcn_permlane32_swap(__float_as_uint(l_reg), __float_as_uint(l_reg), false, false);
    const float lw = __uint_as_float(rr[0]) + __uint_as_float(rr[1]);
    if (hi == 0) L[wid * 32 + r32] = lw; }
  __syncthreads();
  float rli[16];
#pragma unroll
  for (int r = 0; r < 16; ++r) { const int row = crow(r, hi); rli[r] = __builtin_amdgcn_rcpf(L[rg * 32 + row] + L[(rg + 4) * 32 + row]); }
  if (c == 0) {
#pragma unroll
    for (int r = 0; r < 16; ++r) { P0pk[r] = cvtpk(o[0][r] * rli[r], o[1][r] * rli[r]); P0pk[16 + r] = cvtpk(o[2][r] * rli[r], o[3][r] * rli[r]); }
  } else {
    float ssq[16];
#pragma unroll
    for (int r = 0; r < 16; ++r) { ssq[r] = 0.f;
#pragma unroll
      for (int d0 = 0; d0 < 4; ++d0) { const unsigned pk = P0pk[(d0 >> 1) * 16 + r];
        const float p0v = __uint_as_float((d0 & 1) ? (pk & 0xffff0000u) : (pk << 16));
        const float xv = p0v - U.lam * (o[d0][r] * rli[r]); o[d0][r] = xv; ssq[r] += xv * xv; } }
#pragma unroll
    for (int r = 0; r < 16; ++r) {
#pragma unroll
      for (int m = 1; m < 32; m <<= 1) ssq[r] += __shfl_xor(ssq[r], m); }
    float* LS = L + 256;
    if (r32 == 0) {
#pragma unroll
      for (int r = 0; r < 16; ++r) LS[wid * 32 + crow(r, hi)] = ssq[r]; }
    __syncthreads();
    float sg[4];
#pragma unroll
    for (int d0 = 0; d0 < 4; ++d0) sg[d0] = U.subln[x * 128 + d0 * 32 + r32] * U.osc;
    bf16_t* Ow = U.O + (long)(rg * QBLK) * U.ldo + x * 128;
#pragma unroll
    for (int r = 0; r < 16; ++r) { const int orow = crow(r, hi);
      const float rstd = 1.0f / sqrtf((LS[rg * 32 + orow] + LS[(rg + 4) * 32 + orow]) * (1.0f / 256.0f) + 1e-6f);
#pragma unroll
      for (int d0 = 0; d0 < 4; d0 += 2) { const unsigned w = cvtpk(o[d0][r] * rstd * sg[d0], o[d0 + 1][r] * rstd * sg[d0 + 1]);
        Ow[(long)orow * U.ldo + d0 * 32 + r32] = (bf16_t)(w & 0xffffu); Ow[(long)orow * U.ldo + (d0 + 1) * 32 + r32] = (bf16_t)(w >> 16); } }
  }
  __syncthreads();
#undef B_TILE
#undef B_LD8
#undef B_DMAK
#undef B_DMAV
#undef B_END
#undef B_LOADK
#undef B_LOADV
#undef B_WRITEK
#undef B_WRITEV
#undef B_QK
#undef B_SM_EXP
#undef B_SM_PUB
#undef B_PV_SM
#undef B_PV
}
__device__ __forceinline__ void attb_unit(const UnitB& U, char* lds, const int wave_id) {
  unsigned P0pk[32];
  attb_pass<0>(U, lds, wave_id, P0pk);
  attb_pass<1>(U, lds, wave_id, P0pk);
}
}

constexpr int DM = 2048, NCTX = 8192, NLAT = 32768, MTOK = 40960, DFF = 5632, NUP = 11264, DEPTH = 4, NWAVES = 8;
constexpr float EPS = 1e-6f;
constexpr size_t OUT_SAK = 83886080, OUT_SAV = 92274688, OUT_SBK = 100663296, OUT_SBV = 134217728, OUT_END = 167772160;
constexpr size_t MiB = 1u << 20;
constexpr size_t WS_CTL = 0, CTL_ZERO_BYTES = 1 * MiB;
constexpr size_t WS_MOD = 1 * MiB;
constexpr size_t WS_ROPE = 3 * MiB;
constexpr size_t WS_CAK = 4 * MiB, WS_CAV = 12 * MiB, WS_CBK = 20 * MiB, WS_CBV = 52 * MiB;
constexpr size_t WS_WQKV = 84 * MiB, WS_WO = 108 * MiB, WS_WUP = 116 * MiB, WS_WDN = 160 * MiB;
constexpr size_t WS_H = 184 * MiB;
constexpr size_t WS_BIG = 344 * MiB;
constexpr size_t WS_QKV = WS_BIG;
constexpr size_t WS_PART = WS_BIG + 480 * MiB;
constexpr size_t WS_EDGE = WS_BIG;
constexpr size_t WS_ACT = WS_BIG + 440 * MiB;
constexpr size_t WS_A2 = WS_BIG + 32 * MiB;
constexpr size_t WS_ROWSS = WS_BIG + 880 * MiB;
constexpr size_t WS_SHW = WS_ROWSS + 12 * MiB;
constexpr size_t WS_WDN2 = WS_SHW + 3 * MiB;
constexpr size_t WS_END = WS_WDN2 + 22 * MiB;
constexpr int CW_KMAX = 64;
constexpr int CW_BAR = 4096;
constexpr int NPH_LAYER = 8, NPHASES = 1 + DEPTH * NPH_LAYER;
constexpr int RING_OFF = 0, RING_BYTES = 131072;
constexpr int LDSCTL_OFF = RING_BYTES, MISC_OFF = LDSCTL_OFF + 320;
constexpr int XG_OFF = LDSCTL_OFF + 14336;
constexpr int RED_OFF = LDSCTL_OFF + 2048;
constexpr int LDS_BYTES = 147456;

#define GAS __attribute__((address_space(1)))
#define LAS __attribute__((address_space(3)))
typedef unsigned short bf16;
typedef unsigned v4u __attribute__((ext_vector_type(4)));
typedef unsigned v2u __attribute__((ext_vector_type(2)));
typedef float f32x4 __attribute__((ext_vector_type(4)));
typedef float f32x2 __attribute__((ext_vector_type(2)));
typedef GAS unsigned gu32;
#define LDS_WAIT() asm volatile("s_waitcnt lgkmcnt(0)" ::: "memory")
__device__ __forceinline__ unsigned f2bf(float f) { unsigned u = __builtin_bit_cast(unsigned, f); return (u + 0x7fffu + ((u >> 16) & 1u)) >> 16; }
__device__ __forceinline__ unsigned pk2(float lo, float hi) { return f2bf(lo) | (f2bf(hi) << 16); }
__device__ __forceinline__ float bf_lo(unsigned w) { return __builtin_bit_cast(float, w << 16); }
__device__ __forceinline__ float bf_hi(unsigned w) { return __builtin_bit_cast(float, w & 0xffff0000u); }

#define XB_TMO      128
#define XB_XCNT(j)  (256  + 64 * (j))
#define XB_XSUB(j)  (1280 + 64 * (j))
#define XB_XGEN(j)  (2304 + 64 * (j))
#define XB_TOP      3328
#define XB_TOPGEN   3392
#define XCD_BAR_WORDS 3456
#define XB_SPIN_CAP (1u << 18)

__device__ __forceinline__ unsigned xb_ld(unsigned* p)              { return __hip_atomic_load(p, __ATOMIC_RELAXED, __HIP_MEMORY_SCOPE_AGENT); }
__device__ __forceinline__ unsigned xb_add(unsigned* p, unsigned v) { return __hip_atomic_fetch_add(p, v, __ATOMIC_RELAXED, __HIP_MEMORY_SCOPE_AGENT); }
__device__ __forceinline__ unsigned xb_xcc_id() { return (unsigned)__builtin_amdgcn_s_getreg((3 << 11) | 20) & 0xFu; }
#define XB_SPIN(cond, bar) do { unsigned _sp = 0; while (cond) { __builtin_amdgcn_s_sleep(1); \
    if ((++_sp & 255u) == 0u) { if (xb_ld(&(bar)[XB_TMO])) break; if (_sp > XB_SPIN_CAP) { atomicAdd(&(bar)[XB_TMO], 1u); break; } } } } while (0)

struct XcdBarrier {
    unsigned* bar; unsigned x;
    volatile LAS unsigned* st;
};

__device__ __forceinline__ XcdBarrier xcd_barrier_post(unsigned* bar, volatile LAS unsigned* st) {
    XcdBarrier b; b.bar = bar; b.x = xb_xcc_id(); b.st = st;
    if (threadIdx.x == 0) st[2] = xb_add(&bar[XB_XCNT(b.x)], 1u);
    return b;
}
__device__ __forceinline__ void xcd_barrier_complete(unsigned* bar, unsigned x, unsigned& nloc, unsigned& nx) {
    const unsigned G = gridDim.x * gridDim.y * gridDim.z;
    unsigned sum, cnt, mine, sp = 0u;
    for (;;) {
        sum = 0u; cnt = 0u; mine = 0u;
#pragma unroll
        for (unsigned j = 0; j < 16; ++j) { const unsigned c = xb_ld(&bar[XB_XCNT(j)]); sum += c; cnt += (c > 0u) ? 1u : 0u; mine = (j == x) ? c : mine; }
        if (sum == G) break;
        __builtin_amdgcn_s_sleep(1);
        if ((++sp & 255u) == 0u) { if (xb_ld(&bar[XB_TMO])) break; if (sp > XB_SPIN_CAP) { atomicAdd(&bar[XB_TMO], 1u); break; } }
    }
    nloc = mine > 0u ? mine : 1u; nx = cnt > 0u ? cnt : 1u;
}

__device__ __forceinline__ void xcd_barrier(const XcdBarrier& b, const bool is_t0  ) {
    asm volatile("s_waitcnt vmcnt(0)" ::: "memory");
    __syncthreads();
    if (is_t0) {
        unsigned* bar = b.bar;
        __builtin_amdgcn_s_waitcnt(0);
        unsigned nloc = b.st[0], nx = b.st[1];
        if (nloc == 0u) { xcd_barrier_complete(bar, b.x, nloc, nx); b.st[0] = nloc; b.st[1] = nx; }
        const unsigned old = xb_add(&bar[XB_XSUB(b.x)], 1u);
        const unsigned gen = old / nloc;
        if (old + 1u == (gen + 1u) * nloc) {
            __builtin_amdgcn_fence(__ATOMIC_RELEASE, "agent");
            asm volatile("s_waitcnt vmcnt(0)" ::: "memory");
            const unsigned og = xb_add(&bar[XB_TOP], 1u);
            const unsigned tg = og / nx;
            if (og + 1u == (tg + 1u) * nx) xb_add(&bar[XB_TOPGEN], 1u);
            else XB_SPIN(xb_ld(&bar[XB_TOPGEN]) == tg, bar);
            __builtin_amdgcn_fence(__ATOMIC_ACQUIRE, "agent");
            xb_add(&bar[XB_XGEN(b.x)], 1u);
            asm volatile("s_waitcnt vmcnt(0)" ::: "memory");
        } else {
            XB_SPIN(xb_ld(&bar[XB_XGEN(b.x)]) == gen, bar);
            __builtin_amdgcn_fence(__ATOMIC_ACQUIRE, "agent");
            asm volatile("s_waitcnt vmcnt(0)" ::: "memory");
        }
    }
    __syncthreads();
}
struct Args { const float* in[30]; float* out; unsigned char* ws; double rc[32]; double rs[32]; int ph_lo, ph_hi, li, pad; };
struct Frame {
    LAS unsigned char* lds;
    volatile LAS unsigned* MISC;
    gu32* ctl;
    int vcu, G, wave, cg;
    float* out; unsigned char* ws;
};
template <class T> __device__ __forceinline__ T* opaque_ptr(T* p) { size_t z = 0; asm volatile("" : "+s"(z)); return (T*)((char*)p + z); }
__device__ __forceinline__ int opaque_int(int v) { asm volatile("" : "+s"(v)); return v; }
#define PHASE_IDS() int tid_ = (F.wave << 6) | (int)__builtin_amdgcn_mbcnt_hi(~0u, __builtin_amdgcn_mbcnt_lo(~0u, 0u)); asm volatile("" : "+v"(tid_)); const int tid = tid_, lane = tid & 63, wave = F.wave; (void)tid; (void)lane; (void)wave; unsigned char* const WS = opaque_ptr(F.ws); float* const OUT = opaque_ptr(F.out); (void)WS; (void)OUT
__device__ __forceinline__ float wave_sum(float v) {
#pragma unroll
    for (int o = 1; o < 64; o <<= 1) v += __shfl_xor(v, o);
    return v;
}
template <int MODE = 0>
__device__ __forceinline__ void transpose_item(const float* W, int K, int N, bf16* WT, LAS float* scr, int item, int lane, int nqk = 0) {
    const int nblk = N / 64, kb = item / nblk, nb = item % nblk, k0 = 32 * kb, n0 = 64 * nb;
    int r0 = n0; if (MODE == 1) { const int f = n0 < DFF ? n0 : n0 - DFF; r0 = 256 * (f >> 7) + (f & 127) + (n0 < DFF ? 0 : 128); }
    const bool qkperm = (MODE == 2) && ((n0 >> 7) < nqk);
    const float* src = W + (size_t)k0 * N + n0 + lane;
    float v[32];
#pragma unroll
    for (int i = 0; i < 32; ++i) v[i] = src[(size_t)i * N];
#pragma unroll
    for (int i = 0; i < 32; ++i) scr[i * 65 + lane] = v[i];
    LDS_WAIT(); asm volatile("" ::: "memory");
    const int c = lane & 3;
#pragma unroll
    for (int j = 0; j < 4; ++j) { const int n = (lane >> 2) + 16 * j; const LAS float* s = scr + (8 * c) * 65 + n;
        v4u o; o.x = pk2(s[0 * 65], s[1 * 65]); o.y = pk2(s[2 * 65], s[3 * 65]); o.z = pk2(s[4 * 65], s[5 * 65]); o.w = pk2(s[6 * 65], s[7 * 65]);
        const int row = qkperm ? (n0 & ~127) + pg8::qk_row_of_dim((n0 & 127) + n) : r0 + n;
        *(GAS v4u*)(WT + (size_t)row * K + k0 + 8 * c) = o; }
    LDS_WAIT(); asm volatile("" ::: "memory");
}

__device__ __forceinline__ void ph_prologue(Frame& F, const Args& A) {
    PHASE_IDS();
    LAS float* S = (LAS float*)(F.lds + RING_OFF);
    LAS float* red = (LAS float*)(F.lds + RING_OFF + 9 * 2048 * 4);
    const float* c = A.in[6]; const float* cctx = A.in[7]; const float* ada_w = A.in[8]; const float* ada_b = A.in[9];
    float* mod = (float*)(WS + WS_MOD);
    for (int idx = tid; idx < 9 * 2048; idx += 512) { const int r = idx >> 11, k = idx & 2047; const float cv = (r < 8) ? c[r * 2048 + k] : cctx[k]; S[idx] = cv / (1.0f + __expf(-cv)); }
    __syncthreads();
    for (int item = blockIdx.x; item < 4 * 64; item += F.G) {
        const int l = item >> 6, n0 = (item & 63) * 192, k0 = wave * 256;
        f32x4 acc[9];
#pragma unroll
        for (int r = 0; r < 9; ++r) acc[r] = (f32x4){0.f, 0.f, 0.f, 0.f};
        if (lane < 48) {
            const GAS float* W = (const GAS float*)(ada_w + ((size_t)l * 2048 + k0) * 12288 + n0 + 4 * lane);
            f32x4 wa[8], wb[8];
#define GV_LOAD(WW, kk_) do { _Pragma("unroll") for (int i_ = 0; i_ < 8; ++i_) WW[i_] = *(const GAS f32x4*)(W + (size_t)((kk_) + i_) * 12288); asm volatile("" ::: "memory"); } while (0)
#define GV_FMA(WW, kk_) do { _Pragma("unroll") for (int r = 0; r < 9; ++r) { const f32x4 s0 = *(const LAS f32x4*)(S + r * 2048 + k0 + (kk_)), s1 = *(const LAS f32x4*)(S + r * 2048 + k0 + (kk_) + 4); \
                acc[r] += WW[0] * s0.x + WW[1] * s0.y + WW[2] * s0.z + WW[3] * s0.w; acc[r] += WW[4] * s1.x + WW[5] * s1.y + WW[6] * s1.z + WW[7] * s1.w; } } while (0)
            GV_LOAD(wa, 0);
            for (int kk = 0; kk < 256; kk += 16) {
                GV_LOAD(wb, kk + 8);
                GV_FMA(wa, kk);
                GV_LOAD(wa, kk + 16 < 256 ? kk + 16 : kk);
                GV_FMA(wb, kk + 8);
            }
#undef GV_LOAD
#undef GV_FMA
#pragma unroll
            for (int r = 0; r < 9; ++r) *(LAS f32x4*)(red + (wave * 9 + r) * 192 + 4 * lane) = acc[r];
        }
        __syncthreads();
        for (int idx = tid; idx < 9 * 192; idx += 512) { const int r = idx / 192, cc = idx % 192; float s = 0.f;
#pragma unroll
            for (int w = 0; w < 8; ++w) s += red[(w * 9 + r) * 192 + cc];
            mod[(size_t)(l * 9 + r) * 12288 + n0 + cc] = s + ada_b[l * 12288 + n0 + cc]; }
        __syncthreads();
    }
    if (blockIdx.x == 1 && wave < 2) { const int jj = wave; const float linit = 0.8f - 0.6f * expf(-0.3f * (float)(2 * jj + 1));
        const float* q1 = A.in[20] + jj * 128; const float* k1 = A.in[21] + jj * 128; const float* q2 = A.in[22] + jj * 128; const float* k2 = A.in[23] + jj * 128;
        const float d1 = wave_sum(q1[lane] * k1[lane] + q1[lane + 64] * k1[lane + 64]), d2 = wave_sum(q2[lane] * k2[lane] + q2[lane + 64] * k2[lane + 64]);
        if (lane == 0) { float* ls = (float*)(WS + WS_ROPE + 32768); ls[2 * jj] = expf(d1) - expf(d2) + linit; ls[2 * jj + 1] = 1.0f - linit; } }
    if (blockIdx.x == 0 && tid < 32) {
        double c1 = 1.0, s1 = 0.0;
#pragma unroll
        for (int i = 0; i < 32; ++i) if (tid == i) { c1 = A.rc[i]; s1 = A.rs[i]; }
        double cc = 1.0, ss = 0.0; float* tab = (float*)(WS + WS_ROPE);
        for (int p = 0; p < 64; ++p) { tab[p * 64 + tid] = (float)cc; tab[p * 64 + 32 + tid] = (float)ss; const double cn = cc * c1 - ss * s1, sn = ss * c1 + cc * s1; cc = cn; ss = sn; }
    }
    { constexpr size_t NA = 4194304 / 8, NB = 16777216 / 8, TOT = 2 * NA + 2 * NB; float kmx[4] = {0.f, 0.f, 0.f, 0.f};
      const size_t stride = (size_t)F.G * 512;
      for (size_t i0 = (size_t)blockIdx.x * 512 + tid; i0 < TOT; i0 += 4 * stride) {
          f32x4 a4[4], b4[4];
#pragma unroll
          for (int u = 0; u < 4; ++u) { size_t j = i0 + u * stride; if (j >= TOT) j = i0; const float* src;
              if (j < NA) { src = A.in[2]; } else if (j < 2 * NA) { j -= NA; src = A.in[3]; } else if (j < 2 * NA + NB) { j -= 2 * NA; src = A.in[4]; } else { j -= 2 * NA + NB; src = A.in[5]; }
              a4[u] = *(const GAS f32x4*)(src + j * 8); b4[u] = *(const GAS f32x4*)(src + j * 8 + 4); }
          asm volatile("" ::: "memory");
#pragma unroll
          for (int u = 0; u < 4; ++u) { const size_t i = i0 + u * stride; if (i < TOT) { size_t j = i; bf16* dst;
              if (j < NA) { dst = (bf16*)(WS + WS_CAK); } else if (j < 2 * NA) { j -= NA; dst = (bf16*)(WS + WS_CAV); } else if (j < 2 * NA + NB) { j -= 2 * NA; dst = (bf16*)(WS + WS_CBK); } else { j -= 2 * NA + NB; dst = (bf16*)(WS + WS_CBV); }
              const f32x4 a = a4[u], b = b4[u];
              v4u o; o.x = pk2(a.x, a.y); o.y = pk2(a.z, a.w); o.z = pk2(b.x, b.y); o.w = pk2(b.z, b.w);
              *(GAS v4u*)(dst + j * 8) = o;
              float ss = (a.x * a.x + a.y * a.y) + (a.z * a.z + a.w * a.w) + (b.x * b.x + b.y * b.y) + (b.z * b.z + b.w * b.w);
              ss += __shfl_xor(ss, 1); ss += __shfl_xor(ss, 2); ss += __shfl_xor(ss, 4); ss += __shfl_xor(ss, 8);
              const bool isAk = i < NA, isBk = i >= 2 * NA && i < 2 * NA + NB;
              if (isAk || isBk) { const size_t vecidx = j >> 4; const int w_ = (isAk ? 0 : 2) + (isAk ? (int)((vecidx / (512 * 4)) & 1) : (int)((vecidx / (512 * 16)) & 1));
                  kmx[0] = fmaxf(kmx[0], w_ == 0 ? ss : 0.f); kmx[1] = fmaxf(kmx[1], w_ == 1 ? ss : 0.f); kmx[2] = fmaxf(kmx[2], w_ == 2 ? ss : 0.f); kmx[3] = fmaxf(kmx[3], w_ == 3 ? ss : 0.f); } } } }
      LAS float* kred = (LAS float*)(F.lds + RING_OFF);
      __syncthreads();
#pragma unroll
      for (int q = 0; q < 4; ++q) { float m = kmx[q];
#pragma unroll
          for (int o = 1; o < 64; o <<= 1) m = fmaxf(m, __shfl_xor(m, o));
          if (lane == 0) kred[wave * 4 + q] = m; }
      __syncthreads();
      if (tid < 4) { float m = 0.f;
#pragma unroll
          for (int w = 0; w < 8; ++w) m = fmaxf(m, kred[w * 4 + tid]);
          if (m > 0.f) atomicMax((unsigned*)F.ctl + CW_KMAX + tid, __float_as_uint(m)); }
      __syncthreads(); }
}

__device__ __forceinline__ void adaln0_rows(Frame& F, const Args& A) {
    PHASE_IDS();
    const int gw = opaque_int(F.vcu * NWAVES + wave), NGW = F.G * NWAVES;
    const float* g = A.in[10];
    const float* modl = (const float*)(WS + WS_MOD);
    bf16* H = (bf16*)(WS + WS_H); float* rowss = (float*)(WS + WS_ROWSS);
#define AR_LOAD(v, row_) do { const int rw_ = (row_); const GAS float* xr_ = (const GAS float*)(rw_ < NCTX ? A.in[0] + (size_t)rw_ * DM : A.in[1] + (size_t)(rw_ - NCTX) * DM) + 4 * lane; \
        _Pragma("unroll") for (int j_ = 0; j_ < 8; ++j_) v[j_] = *(const GAS f32x4*)(xr_ + 256 * j_); asm volatile("" ::: "memory"); } while (0)
#define AR_PROC(v, row_) do { const int rw_ = (row_); const int cond_ = rw_ < NCTX ? 8 : ((rw_ - NCTX) >> 12); const float* sc_ = modl + (size_t)cond_ * 12288 + DM; float ss_ = 0.f; \
        _Pragma("unroll") for (int j_ = 0; j_ < 8; ++j_) { ss_ += (v[j_].x * v[j_].x + v[j_].y * v[j_].y) + (v[j_].z * v[j_].z + v[j_].w * v[j_].w); *(GAS f32x4*)(OUT + (size_t)rw_ * DM + 4 * lane + 256 * j_) = v[j_]; } \
        ss_ = wave_sum(ss_); \
        if (lane < 8) rowss[(size_t)rw_ * 8 + lane] = lane == 0 ? ss_ : 0.f; \
        _Pragma("unroll") for (int j_ = 0; j_ < 8; ++j_) { const int col_ = 4 * lane + 256 * j_; \
            const f32x4 gg_ = *(const f32x4*)(g + col_), s1_ = *(const f32x4*)(sc_ + col_); \
            const f32x4 y_ = v[j_] * gg_ * (s1_ + 1.0f); \
            v2u o_; o_.x = pk2(y_.x, y_.y); o_.y = pk2(y_.z, y_.w); \
            *(GAS v2u*)(H + (size_t)rw_ * DM + col_) = o_; } } while (0)
    int row = gw;
    f32x4 va[8], vb[8];
    if (row < MTOK) AR_LOAD(va, row);
    while (row < MTOK) {
        const int r1 = row + NGW;
        AR_LOAD(vb, r1 < MTOK ? r1 : row);
        AR_PROC(va, row);
        if (r1 >= MTOK) break;
        const int r2 = r1 + NGW;
        AR_LOAD(va, r2 < MTOK ? r2 : r1);
        AR_PROC(vb, r1);
        row = r2;
    }
#undef AR_LOAD
#undef AR_PROC
}
__device__ __forceinline__ void shw_gemv_all(Frame& F, const Args& A) {
    PHASE_IDS();
    LAS float* S = (LAS float*)(F.lds + RING_OFF); LAS float* red = (LAS float*)(F.lds + RING_OFF + 9 * 2048 * 4);
    for (int item = blockIdx.x; item < 248; item += F.G) {
        int layer, isup, cg;
        if (item < 72) { isup = 0; int r = item; layer = 0; while (true) { const int n = (layer & 1) ? 24 : 12; if (r < n) break; r -= n; ++layer; } cg = r; }
        else { isup = 1; layer = (item - 72) / 44; cg = (item - 72) % 44; }
        const int j = layer >> 1; const bool isB = layer & 1; const int N = isup ? NUP : (isB ? 6144 : 3072), nqk = isB ? 32 : 20;
        const float* W = isup ? A.in[26] + (size_t)layer * DM * NUP : (isB ? A.in[17] + (size_t)j * DM * 6144 : A.in[12] + (size_t)j * DM * 3072);
        const float* sh = (const float*)(WS + WS_MOD) + (size_t)layer * 9 * 12288 + (isup ? 3 * DM : 0);
        float* out = (float*)(WS + WS_SHW) + (size_t)layer * 9 * 17408 + (isup ? 9 * 6144 : 0);
        __syncthreads();
        for (int idx = tid; idx < 9 * 2048; idx += 512) S[idx] = sh[(size_t)(idx >> 11) * 12288 + (idx & 2047)];
        __syncthreads();
        const int n0 = cg * 256, k0 = wave * 256;
        const GAS float* Wp = (const GAS float*)(W + (size_t)k0 * N + n0 + 4 * lane);
        f32x4 acc[9];
#pragma unroll
        for (int r = 0; r < 9; ++r) acc[r] = (f32x4){0.f, 0.f, 0.f, 0.f};
        { f32x4 wa[8], wb[8];
#define GV_LOAD(WW, kk_) do { _Pragma("unroll") for (int i_ = 0; i_ < 8; ++i_) WW[i_] = *(const GAS f32x4*)(Wp + (size_t)((kk_) + i_) * N); asm volatile("" ::: "memory"); } while (0)
#define GV_FMA(WW, kk_) do { _Pragma("unroll") for (int r = 0; r < 9; ++r) { const f32x4 s0 = *(const LAS f32x4*)(S + r * 2048 + k0 + (kk_)), s1 = *(const LAS f32x4*)(S + r * 2048 + k0 + (kk_) + 4); \
            acc[r] += WW[0] * s0.x + WW[1] * s0.y + WW[2] * s0.z + WW[3] * s0.w; acc[r] += WW[4] * s1.x + WW[5] * s1.y + WW[6] * s1.z + WW[7] * s1.w; } } while (0)
          GV_LOAD(wa, 0);
          for (int kk = 0; kk < 256; kk += 16) {
              GV_LOAD(wb, kk + 8);
              GV_FMA(wa, kk);
              GV_LOAD(wa, kk + 16 < 256 ? kk + 16 : kk);
              GV_FMA(wb, kk + 8);
          }
#undef GV_LOAD
#undef GV_FMA
        }
#pragma unroll
        for (int half = 0; half < 2; ++half) {
            if ((lane >> 5) == half) {
#pragma unroll
                for (int r = 0; r < 9; ++r) *(LAS f32x4*)(red + (wave * 9 + r) * 128 + 4 * (lane & 31)) = acc[r]; }
            __syncthreads();
            for (int idx = tid; idx < 9 * 128; idx += 512) { const int r = idx >> 7, cc = idx & 127, n = n0 + half * 128 + cc; float s = 0.f;
#pragma unroll
                for (int w = 0; w < 8; ++w) s += red[(w * 9 + r) * 128 + cc];
                int lc = n;
                if (isup) { const int f = n < DFF ? n : n - DFF; lc = 256 * (f >> 7) + (f & 127) + (n < DFF ? 0 : 128); }
                else if ((n >> 7) < nqk) lc = (n & ~127) + pg8::qk_row_of_dim(n & 127);
                out[(size_t)r * N + lc] = s; }
            __syncthreads();
        }
    }
}
struct CvtItem { const float* W; bf16* WT; int K, N, item, mode, nqk; };
#define CVT_LOAD(v, d) do { const int nblk_ = (d).N / 64, kb_ = (d).item / nblk_, nb_ = (d).item % nblk_; const GAS float* src_ = (const GAS float*)((d).W + (size_t)(32 * kb_) * (d).N + 64 * nb_) + lane; \
    _Pragma("unroll") for (int i_ = 0; i_ < 32; ++i_) v[i_] = src_[(size_t)i_ * (d).N]; asm volatile("" ::: "memory"); } while (0)
#define CVT_STORE(v, d) do { const int nblk_ = (d).N / 64, kb_ = (d).item / nblk_, nb_ = (d).item % nblk_, k0_ = 32 * kb_, n0_ = 64 * nb_; \
    int r0_ = n0_; if ((d).mode == 1) { const int f_ = n0_ < DFF ? n0_ : n0_ - DFF; r0_ = 256 * (f_ >> 7) + (f_ & 127) + (n0_ < DFF ? 0 : 128); } \
    const bool qkperm_ = ((d).mode == 2) && ((n0_ >> 7) < (d).nqk); \
    _Pragma("unroll") for (int i_ = 0; i_ < 32; ++i_) scr[i_ * 65 + lane] = v[i_]; \
    LDS_WAIT(); asm volatile("" ::: "memory"); \
    const int c_ = lane & 3; \
    _Pragma("unroll") for (int j_ = 0; j_ < 4; ++j_) { const int n_ = (lane >> 2) + 16 * j_; const LAS float* s_ = scr + (8 * c_) * 65 + n_; \
        v4u o_; o_.x = pk2(s_[0 * 65], s_[1 * 65]); o_.y = pk2(s_[2 * 65], s_[3 * 65]); o_.z = pk2(s_[4 * 65], s_[5 * 65]); o_.w = pk2(s_[6 * 65], s_[7 * 65]); \
        const int row_ = qkperm_ ? (n0_ & ~127) + pg8::qk_row_of_dim((n0_ & 127) + n_) : r0_ + n_; \
        *(GAS v4u*)((d).WT + (size_t)row_ * (d).K + k0_ + 8 * c_) = o_; } \
    LDS_WAIT(); asm volatile("" ::: "memory"); } while (0)
__device__ __forceinline__ void convert_weights(Frame& F, const Args& A, int layer, int sel, int rank, int nrank) {
    PHASE_IDS();
    LAS float* scr = (LAS float*)(F.lds + RING_OFF + wave * 16384);
    const int gw = opaque_int(rank * NWAVES + wave), NGW = nrank * NWAVES;
    const int j = layer >> 1; const bool isB = layer & 1; const int NQ = isB ? 6144 : 3072;
    const float* Wqkv = isB ? A.in[17] + (size_t)j * DM * 6144 : A.in[12] + (size_t)j * DM * 3072;
    const float* Wo = (isB ? A.in[25] : A.in[16]) + (size_t)j * DM * DM;
    const float* Wup = A.in[26] + (size_t)layer * DM * NUP; const float* Wdn = A.in[29] + (size_t)layer * DFF * DM;
    const int I_Q = (sel & 1) ? (DM / 32) * (NQ / 64) : 0, I_O = (sel & 2) ? (DM / 32) * (DM / 64) : 0, I_U = (sel & 4) ? (DM / 32) * (NUP / 64) : 0, I_D = (sel & 8) ? (DFF / 32) * (DM / 64) : 0;
    const int NITEMS = I_Q + I_O + I_U + I_D;
    auto decode = [&](int it) -> CvtItem { CvtItem d; int r = it;
        if (r < I_Q) { d.W = Wqkv; d.WT = (bf16*)(WS + WS_WQKV); d.K = DM; d.N = NQ; d.item = r; d.mode = 2; d.nqk = isB ? 32 : 20; return d; } r -= I_Q;
        if (r < I_O) { d.W = Wo; d.WT = (bf16*)(WS + WS_WO); d.K = DM; d.N = DM; d.item = r; d.mode = 0; d.nqk = 0; return d; } r -= I_O;
        if (r < I_U) { d.W = Wup; d.WT = (bf16*)(WS + WS_WUP); d.K = DM; d.N = NUP; d.item = r; d.mode = 1; d.nqk = 0; return d; } r -= I_U;
        d.W = Wdn; d.WT = (bf16*)(WS + ((layer & 1) ? WS_WDN2 : WS_WDN)); d.K = DFF; d.N = DM; d.item = r; d.mode = 0; d.nqk = 0; return d; };
    int it = gw;
    float va[32], vb[32];
    if (it < NITEMS) { const CvtItem d = decode(it); CVT_LOAD(va, d); }
    while (it < NITEMS) {
        const int n1 = it + NGW;
        { const CvtItem d = decode(n1 < NITEMS ? n1 : it); CVT_LOAD(vb, d); }
        { const CvtItem d = decode(it); CVT_STORE(va, d); }
        if (n1 >= NITEMS) break;
        const int n2 = n1 + NGW;
        { const CvtItem d = decode(n2 < NITEMS ? n2 : n1); CVT_LOAD(va, d); }
        { const CvtItem d = decode(n1); CVT_STORE(vb, d); }
        it = n2;
    }
}

__device__ __forceinline__ void attention_phase(Frame& F, const Args& A, int layer, char* lds) {
    unsigned char* const WS = opaque_ptr(F.ws);
    const int j = layer >> 1; const bool isB = layer & 1;
    const bf16* QKV = (const bf16*)(WS + WS_QKV);
    const int nlat = 2048, nctx = 512, ntot = nlat + nctx;
    float mbound;
    { int lane = (int)__builtin_amdgcn_mbcnt_hi(~0u, __builtin_amdgcn_mbcnt_lo(~0u, 0u)); asm volatile("" : "+v"(lane));
      const float* gq = (isB ? A.in[18] : A.in[13]) + j * 128; const float* gk = (isB ? A.in[19] : A.in[14]) + j * 128;
      float mq = fmaxf(fabsf(gq[lane]), fabsf(gq[lane + 64])), mk = fmaxf(fabsf(gk[lane]), fabsf(gk[lane + 64]));
#pragma unroll
      for (int o = 1; o < 64; o <<= 1) { mq = fmaxf(mq, __shfl_xor(mq, o)); mk = fmaxf(mk, __shfl_xor(mk, o)); }
      const float kc = sqrtf(__uint_as_float(__hip_atomic_load((unsigned*)F.ctl + CW_KMAX + (isB ? 2 : 0) + j, __ATOMIC_RELAXED, __HIP_MEMORY_SCOPE_AGENT)));
      mbound = __builtin_amdgcn_readfirstlane(11.313708499f * mq * fmaxf(11.313708499f * mk, kc) * 1.01f); }
    const float lamB = ((const float*)(WS + WS_ROPE + 32768))[2 * j], oscB = ((const float*)(WS + WS_ROPE + 32768))[2 * j + 1];
    for (int u = F.vcu; u < ntot; u += F.G) {
        att::Unit U;
        if (!isB) {
            bf16* O = (bf16*)(WS + WS_H);
            const float* sink = A.in[15] + j * 16;
            U.ldq = 3072; U.ld0 = 3072; U.ld1 = 512; U.ldo = 2048; U.m_init = mbound;
            if (u < nlat) { const int qt = u & 15, h = (u >> 4) & 15, b = u >> 8, kvh = h >> 2;
                const int ks = (qt * 256 - 128) < 0 ? 0 : qt * 256 - 128, ke = (qt * 256 + 384) > 4096 ? 4096 : qt * 256 + 384;
                const size_t r0 = (size_t)NCTX + (size_t)b * 4096;
                U.Q = QKV + (r0 + qt * 256) * 3072 + h * 128; U.O = O + (r0 + qt * 256) * 2048 + h * 128;
                U.K0 = QKV + (r0 + ks) * 3072 + 2048 + kvh * 128; U.V0 = U.K0 + 512; U.n0 = (ke - ks) >> 6;
                const size_t cb = ((size_t)(b * 2 + j) * 512) * 512 + kvh * 128;
                U.K1 = (const bf16*)(WS + WS_CAK) + cb; U.V1 = (const bf16*)(WS + WS_CAV) + cb; U.n1 = 8;
                U.mask = 1; U.qpos0 = qt * 256; U.kpos0 = ks; U.l_init = __expf(sink[h] - mbound * att::SCALE);
            } else { const int uu = u - nlat, h = uu & 15, b = uu >> 4, kvh = h >> 2; const size_t r0 = (size_t)b * 256;
                U.Q = QKV + r0 * 3072 + h * 128; U.O = O + r0 * 2048 + h * 128;
                U.K0 = QKV + r0 * 3072 + 2048 + kvh * 128; U.V0 = U.K0 + 512; U.n0 = 4;
                U.K1 = U.K0; U.V1 = U.V0; U.n1 = 0; U.mask = 0; U.qpos0 = 0; U.kpos0 = 0; U.l_init = __expf(sink[h] - mbound * att::SCALE);
            }
        } else {
            { att::UnitB UB; UB.ldq = 6144; UB.ld0 = 6144; UB.ld1 = 2048; UB.ldo = 2048; UB.m_bound = mbound; UB.lam = lamB; UB.osc = oscB; UB.subln = A.in[24] + j * 256;
                size_t orow; int h;
                if (u < 2048) { const int qt = u & 31; h = (u >> 5) & 7; const int b = u >> 8;
                    const size_t r0 = (size_t)NCTX + (size_t)b * 4096; orow = r0 + qt * 128;
                    UB.Q = QKV + orow * 6144 + (h * 2) * 128;
                    UB.K0 = QKV + r0 * 6144 + 2048 + (h * 2) * 128; UB.V0 = QKV + r0 * 6144 + 4096 + h * 256; UB.n0 = 64;
                    const size_t cb = ((size_t)(b * 2 + j) * 512) * 2048;
                    UB.K1 = (const bf16*)(WS + WS_CBK) + cb + (h * 2) * 128; UB.V1 = (const bf16*)(WS + WS_CBV) + cb + h * 256; UB.n1 = 8;
                } else { const int uu = u - 2048, qt = uu & 1; h = (uu >> 1) & 7; const int b = uu >> 4; const size_t r0 = (size_t)b * 256; orow = r0 + qt * 128;
                    UB.Q = QKV + orow * 6144 + (h * 2) * 128;
                    UB.K0 = QKV + r0 * 6144 + 2048 + (h * 2) * 128; UB.V0 = QKV + r0 * 6144 + 4096 + h * 256; UB.n0 = 4;
                    UB.K1 = UB.K0; UB.V1 = UB.V0; UB.n1 = 0;
                }
                UB.O = (bf16*)(WS + WS_H) + orow * 2048 + h * 256;
                att::attb_unit(UB, lds, F.wave);
            }
            continue;
        }
        att::attn_unit(U, lds, F.wave);
    }
}

__device__ __forceinline__ void diff_combine(Frame& F, const Args& A, int layer) {
    PHASE_IDS();
    const int gw = F.vcu * NWAVES + wave, NGW = F.G * NWAVES; const int j = layer >> 1;
    const float linit = 0.8f - 0.6f * expf(-0.3f * (float)layer);
    float d1, d2;
    { const float* q1 = A.in[20] + j * 128; const float* k1 = A.in[21] + j * 128; const float* q2 = A.in[22] + j * 128; const float* k2 = A.in[23] + j * 128;
      d1 = wave_sum(q1[lane] * k1[lane] + q1[lane + 64] * k1[lane + 64]); d2 = wave_sum(q2[lane] * k2[lane] + q2[lane + 64] * k2[lane + 64]); }
    const float lam = expf(d1) - expf(d2) + linit, osc = 1.0f - linit;
    const f32x4 sg = *(const f32x4*)(A.in[24] + j * 256 + 4 * lane);
    const bf16* P0 = (const bf16*)(WS + WS_PART); const bf16* P1 = P0 + (size_t)MTOK * 2048; bf16* O = (bf16*)(WS + WS_H);
    for (int it = gw; it < MTOK * 8; it += NGW) {
        const size_t off = (size_t)it * 256 + 4 * lane;
        const v2u a = *(const v2u*)(P0 + off), b = *(const v2u*)(P1 + off);
        const float x0 = bf_lo(a.x) - lam * bf_lo(b.x), x1 = bf_hi(a.x) - lam * bf_hi(b.x), x2 = bf_lo(a.y) - lam * bf_lo(b.y), x3 = bf_hi(a.y) - lam * bf_hi(b.y);
        const float rstd = osc / sqrtf(wave_sum((x0 * x0 + x1 * x1) + (x2 * x2 + x3 * x3)) * (1.0f / 256.0f) + EPS);
        v2u o; o.x = pk2(x0 * rstd * sg.x, x1 * rstd * sg.y); o.y = pk2(x2 * rstd * sg.z, x3 * rstd * sg.w);
        *(v2u*)(O + off) = o;
    }
}

__device__ __forceinline__ void convglu_fixup(Frame& F, const Args& A, int layer) {
    PHASE_IDS();
    const float* EDGE = (const float*)(WS + WS_EDGE); bf16* ACT = (bf16*)(WS + WS_ACT);
    const float* cw = A.in[27] + (size_t)layer * 3 * DFF; const float* cb = A.in[28] + (size_t)layer * DFF;
    constexpr int NF4 = DFF / 4;
    for (int it = blockIdx.x * 512 + tid; it < 120 * NF4; it += F.G * 512) {
        const int bd = it / NF4, f = (it % NF4) * 4, pm = 32 + (bd / 15) * 16 + (bd % 15);
        const float* el = EDGE + (size_t)pm * 6 * DFF + f; const float* er = el + 6 * DFF;
        const f32x4 gA1 = *(const f32x4*)(el), gA = *(const f32x4*)(el + DFF), vA = *(const f32x4*)(el + 2 * DFF);
        const f32x4 gB = *(const f32x4*)(er + 3 * DFF), gB1 = *(const f32x4*)(er + 4 * DFF), vB = *(const f32x4*)(er + 5 * DFF);
        const f32x4 w0 = *(const f32x4*)(cw + f), w1 = *(const f32x4*)(cw + DFF + f), w2 = *(const f32x4*)(cw + 2 * DFF + f), bb = *(const f32x4*)(cb + f);
        const f32x4 sa = w0 * gA1 + w1 * gA + w2 * gB + bb, sb = w0 * gA + w1 * gB + w2 * gB1 + bb;
        float a[4], b2[4];
#pragma unroll
        for (int k = 0; k < 4; ++k) { a[k] = sa[k] / (1.0f + __expf(-sa[k])) * vA[k]; b2[k] = sb[k] / (1.0f + __expf(-sb[k])) * vB[k]; }
        v2u oa, ob; oa.x = pk2(a[0], a[1]); oa.y = pk2(a[2], a[3]); ob.x = pk2(b2[0], b2[1]); ob.y = pk2(b2[2], b2[3]);
        *(v2u*)(ACT + (size_t)(pm * 256 + 255) * DFF + f) = oa; *(v2u*)(ACT + (size_t)(pm * 256 + 256) * DFF + f) = ob;
    }
}

__global__ void __launch_bounds__(NWAVES * 64, 2) mk_fwd(Args args) {
    extern __shared__ __attribute__((aligned(16))) unsigned char lds[];
    Frame F;
    F.lds = (LAS unsigned char*)lds;
    F.MISC = (volatile LAS unsigned*)(F.lds + MISC_OFF);
    F.wave = __builtin_amdgcn_readfirstlane((int)threadIdx.x >> 6);
    F.G = gridDim.x; { const int bx = blockIdx.x; F.vcu = (F.G % 8 == 0) ? (bx % 8) * (F.G / 8) + bx / 8 : bx; }
    F.cg = (int)blockIdx.x;
    F.ws = args.ws; F.out = args.out; F.ctl = (gu32*)(args.ws + WS_CTL);
    for (int u = threadIdx.x; u < (LDS_BYTES - LDSCTL_OFF) / 4; u += NWAVES * 64) ((LAS unsigned*)(F.lds + LDSCTL_OFF))[u] = 0u;
    __syncthreads();
    XcdBarrier bar = xcd_barrier_post((unsigned*)(F.ctl + CW_BAR) + args.li * XCD_BAR_WORDS, F.MISC + 8);
    const int lo = args.ph_lo, hi = args.ph_hi;
#ifndef SITES
#define SITES 0xFFFF
#endif
#define SITE(n) ((SITES >> (n)) & 1)
#ifndef DUPMASK
#define DUPMASK 0
#endif
#define NREP(n) (1 + ((DUPMASK >> (n)) & 1))
#define IN(k) (lo <= (k) && (k) < hi)
#define SEAM(k) do { if ((k) + 1 < hi) { const int t_ = (F.wave << 6) | (int)__builtin_amdgcn_mbcnt_hi(~0u, __builtin_amdgcn_mbcnt_lo(~0u, 0u)); XcdBarrier b_ = bar; b_.bar = opaque_ptr(b_.bar); xcd_barrier(b_, t_ == 0); } } while (0)

    if (SITE(12) && IN(0)) { ph_prologue(F, args); SEAM(0); }
    if (lo == 0 && hi > 1 && (F.G & 7) == 0) {
        if (threadIdx.x == 0) { unsigned pre = 0; for (unsigned jx = 0; jx < bar.x; ++jx) pre += xb_ld(&bar.bar[XB_XCNT(jx)]); F.MISC[11] = pre + F.MISC[10]; }
        __syncthreads();
        const int v = __builtin_amdgcn_readfirstlane((int)F.MISC[11]), per = F.G >> 3;
        F.vcu = v; F.cg = (v % per) * 8 + v / per;
    }

    for (int layer = 0; layer < DEPTH; ++layer) {
        const int pb = 1 + layer * NPH_LAYER; const bool isB = layer & 1; const int NQ = isB ? 6144 : 3072;
        if (SITE(0) && IN(pb + 0)) { if (layer == 0) { convert_weights(F, args, 0, 15, F.vcu, F.G); __syncthreads(); shw_gemv_all(F, args); adaln0_rows(F, args); SEAM(pb + 0); } }
        if (SITE(1) && IN(pb + 1)) { unsigned char* const WS = opaque_ptr(F.ws); float* const OUT = opaque_ptr(F.out); const int jl = layer >> 1;
            pg8::Gemm g{(const bf16*)(WS + WS_H), (const bf16*)(WS + WS_WQKV), MTOK, NQ, DM}; pg8::StaticOrder S; S.init(MTOK, NQ, F.G, F.cg, 8);
            pg8::EpiQKV E{(bf16*)(WS + WS_QKV), NQ, isB ? 32 : 20, (isB ? args.in[18] : args.in[13]) + jl * 128, (isB ? args.in[19] : args.in[14]) + jl * 128, (const float*)(WS + WS_ROPE),
                          OUT + (isB ? OUT_SBK : OUT_SAK), OUT + (isB ? OUT_SBV : OUT_SAV), isB ? 2048 : 512, jl, (LAS float*)(F.lds + RED_OFF),
                          (const float*)(WS + WS_ROWSS) + (size_t)(2 * layer) * MTOK * 8, (const float*)(WS + WS_SHW) + (size_t)layer * 9 * 17408};
            for (int rep = 0; rep < NREP(1); ++rep) pg8::gemm_phase<pg8::EpiQKV, pg8::StaticOrder, true, true>(F.lds + RING_OFF, g, S, E, F.wave);
            if (!isB && layer + 1 < DEPTH) { const int rem = S.nwg % F.G;
                if (rem == 0) convert_weights(F, args, layer + 1, 8, F.vcu, F.G); else if (F.cg >= rem) convert_weights(F, args, layer + 1, 8, F.cg - rem, F.G - rem); }
            SEAM(pb + 1);
        }
        if (SITE(3) && IN(pb + 2)) { for (int rep = 0; rep < NREP(3); ++rep) attention_phase(F, args, layer, (char*)lds + RING_OFF); SEAM(pb + 2); }
        if (SITE(5) && IN(pb + 4)) { unsigned char* const WS = opaque_ptr(F.ws); float* const OUT = opaque_ptr(F.out);
            pg8::Gemm g{(const bf16*)(WS + WS_H), (const bf16*)(WS + WS_WO), MTOK, DM, DM}; pg8::StaticOrder S; S.init(MTOK, DM, F.G, F.cg, 4);
            pg8::EpiGate E{OUT, (const float*)(WS + WS_MOD) + (size_t)layer * 9 * 12288 + 2 * DM,
                           (bf16*)(WS + WS_A2), args.in[11] + layer * DM, (const float*)(WS + WS_MOD) + (size_t)layer * 9 * 12288 + 4 * DM, (float*)(WS + WS_ROWSS) + (size_t)(2 * layer + 1) * MTOK * 8, (LAS float*)(F.lds + RED_OFF)};
            pg8::gemm_phase<pg8::EpiGate, pg8::StaticOrder, true, true>(F.lds + RING_OFF, g, S, E, F.wave);
            SEAM(pb + 4);
        }
        if (SITE(7) && IN(pb + 5)) { unsigned char* const WS = opaque_ptr(F.ws);
            pg8::Gemm g{(const bf16*)(WS + WS_A2), (const bf16*)(WS + WS_WUP), MTOK, NUP, DM}; pg8::StaticOrder S; S.init(MTOK, NUP, F.G, F.cg, 4);
            pg8::EpiConvGlu E{(bf16*)(WS + WS_ACT), args.in[27] + (size_t)layer * 3 * DFF, args.in[28] + (size_t)layer * DFF, (float*)(WS + WS_EDGE), (LAS float*)(F.lds + XG_OFF),
                               (const float*)(WS + WS_ROWSS) + (size_t)(2 * layer + 1) * MTOK * 8, (const float*)(WS + WS_SHW) + (size_t)layer * 9 * 17408 + 9 * 6144};
            pg8::gemm_phase<pg8::EpiConvGlu, pg8::StaticOrder, true, true, true>(F.lds + RING_OFF, g, S, E, F.wave);
            if (layer + 1 < DEPTH) { const int rem = S.nwg % F.G;
                if (rem == 0) convert_weights(F, args, layer + 1, 3, F.vcu, F.G); else if (F.cg >= rem) convert_weights(F, args, layer + 1, 3, F.cg - rem, F.G - rem); }
            SEAM(pb + 5);
        }
        if (SITE(8) && IN(pb + 6)) { convglu_fixup(F, args, layer); if (layer + 1 < DEPTH) convert_weights(F, args, layer + 1, isB ? 12 : 4, F.vcu, F.G); SEAM(pb + 6); }
        if (SITE(11) && IN(pb + 7)) { unsigned char* const WS = opaque_ptr(F.ws); float* const OUT = opaque_ptr(F.out);
            pg8::Gemm g{(const bf16*)(WS + WS_ACT), (const bf16*)(WS + ((layer & 1) ? WS_WDN2 : WS_WDN)), MTOK, DM, DFF}; pg8::StaticOrder S; S.init(MTOK, DM, F.G, F.cg, 4);
            const int nl = layer + 1 < DEPTH ? layer + 1 : layer; const bool last = layer + 1 == DEPTH;
            pg8::EpiGate E{OUT, (const float*)(WS + WS_MOD) + (size_t)layer * 9 * 12288 + 5 * DM,
                           last ? (bf16*)nullptr : (bf16*)(WS + WS_H), args.in[10] + nl * DM, (const float*)(WS + WS_MOD) + (size_t)nl * 9 * 12288 + 1 * DM, (float*)(WS + WS_ROWSS) + (size_t)(2 * nl) * MTOK * 8, (LAS float*)(F.lds + RED_OFF)};
            pg8::gemm_phase<pg8::EpiGate, pg8::StaticOrder, true, true>(F.lds + RING_OFF, g, S, E, F.wave);
            SEAM(pb + 7);
        }
    }
#undef IN
#undef SEAM
}

#ifndef MK_N_LAUNCHES
#define MK_N_LAUNCHES 1
#endif
extern "C" void kernel_launch(void* const* d_in, const int* in_sizes, int n_in, void* d_out, int out_size, void* d_ws, size_t ws_size, hipStream_t stream) {
    static int grid = 0;
    if (grid == 0) {
        if (n_in != 30 || (size_t)out_size != OUT_END || ws_size < WS_END) { fprintf(stderr, "kernel_launch: unexpected shapes: n_in %d out %d ws %zu (need %zu)\n", n_in, out_size, ws_size, (size_t)WS_END); grid = -1; return; }
        int dev = 0, cus = 0, per_cu = 0;
        if (hipGetDevice(&dev) != hipSuccess || hipDeviceGetAttribute(&cus, hipDeviceAttributeMultiprocessorCount, dev) != hipSuccess) { grid = -1; return; }
        if (hipFuncSetAttribute((const void*)mk_fwd, hipFuncAttributeMaxDynamicSharedMemorySize, LDS_BYTES) != hipSuccess) { fprintf(stderr, "kernel_launch: hipFuncSetAttribute failed\n"); grid = -1; return; }
        if (hipOccupancyMaxActiveBlocksPerMultiprocessor(&per_cu, (const void*)mk_fwd, NWAVES * 64, LDS_BYTES) != hipSuccess || per_cu < 1) { fprintf(stderr, "kernel_launch: occupancy query says %d blocks per CU\n", per_cu); }
        (void)hipGetLastError();
        grid = cus;
    }
    if (grid < 0) return;
    if (hipMemsetAsync((char*)d_ws + WS_CTL, 0, CTL_ZERO_BYTES, stream) != hipSuccess) return;
    Args a{};
    for (int i = 0; i < 30; ++i) a.in[i] = (const float*)d_in[i];
    a.out = (float*)d_out; a.ws = (unsigned char*)d_ws;
    for (int i = 0; i < 32; ++i) { const double th = pow(10000.0, -(double)i / 32.0); a.rc[i] = cos(th); a.rs[i] = sin(th); }
    constexpr int NL = MK_N_LAUNCHES;
    for (int li = 0; li < NL; ++li) {
        a.ph_lo = (NL == 1) ? 0 : li; a.ph_hi = (NL == 1) ? NPHASES : li + 1; a.li = li; a.pad = 0;
        hipLaunchKernelGGL(mk_fwd, dim3(grid), dim3(NWAVES * 64), LDS_BYTES, stream, a);
        const hipError_t le = hipPeekAtLastError();
        if (le != hipSuccess) { fprintf(stderr, "kernel_launch: launch %d failed: %s\n", li, hipGetErrorName(le)); break; }
    }
}
```

```cpp
#include <hip/hip_runtime.h>
#include <cstdio>
#include <cstdint>
#include <cmath>
namespace pg8 {
#define PG8_LAS __attribute__((address_space(3)))
typedef unsigned short bf16_t;
typedef short bf16x8 __attribute__((ext_vector_type(8)));
typedef float f32x4 __attribute__((ext_vector_type(4)));
typedef unsigned u32x4 __attribute__((ext_vector_type(4)));
constexpr int BM = 256, BK = 64, HALF = 128, HTB = HALF * BK * 2  , STAGE_BYTES = 8 * HTB, NXCD = 8, WGM = 8;

__host__ __device__ __forceinline__ int lds_byte(int r, int c) { const int st = (r >> 4) * 2 + (c >> 5), rr = r & 15, cc = c & 31, ob = rr * 64 + cc * 2; return st * 1024 + (ob ^ (((ob >> 9) & 1) << 5)); }
__host__ __device__ __forceinline__ void stage_rc(int b, int& R, int& C) { const int st = b / 1024, sb = b % 1024, swz = sb ^ (((sb >> 9) & 1) << 5); R = (st >> 1) * 16 + swz / 64; C = (st & 1) * 32 + (swz % 64) / 2; }
__host__ __device__ __forceinline__ int perm32(int rho) { const int n = rho >> 4, i = rho & 15; return 8 * (i >> 2) + 4 * n + (i & 3); }

struct Unit { int pm, pn; };
struct Gemm { const bf16_t* A; const bf16_t* Bt; int M, N, K; };

struct StaticOrder {
    int nM, nN, nwg, G, c, wgm;
    __host__ __device__ void init(int M, int N, int G_, int c_, int wgm_ = WGM) { nM = M / BM; nN = N / BM; nwg = nM * nN; G = G_; c = c_; wgm = wgm_; }
    __host__ __device__ bool next(int i, Unit& u) const {
        const long L = (long)i * G + c; if (L >= nwg) return false;
        int wgid = (int)L; { const int q = nwg / NXCD, r = nwg % NXCD, xcd = wgid % NXCD, off = wgid / NXCD; wgid = (xcd < r ? xcd * (q + 1) : r * (q + 1) + (xcd - r) * q) + off; }
        const int nig = wgm * nN, gid = wgid / nig, fm = gid * wgm, gsz = (nM - fm) < wgm ? (nM - fm) : wgm;
        u.pm = fm + ((wgid % nig) % gsz); u.pn = (wgid % nig) / gsz; return true;
    }
    __device__ __forceinline__ void a_ready(const Unit&) const {}
    __device__ __forceinline__ void done(const Unit&) const {}
};

__device__ __forceinline__ unsigned cvt_pk_bf16(float lo, float hi) { unsigned r; asm volatile("v_cvt_pk_bf16_f32 %0, %1, %2" : "=v"(r) : "v"(lo), "v"(hi)); return r; }
typedef float f32x2 __attribute__((ext_vector_type(2)));
struct EpiBf16 {
    static constexpr bool PERM = true, AFTER_DRAIN = false;
    bf16_t* O; int ldc;
    __device__ __forceinline__ void operator()(const f32x4 (&acc)[2][2][4][2], const Unit& u, int wr, int wc, int fr, int fq) const {
        const int row0 = u.pm * BM + wr * 64 + fr, col0 = u.pn * BM + wc * 32 + 8 * fq;
#pragma unroll
        for (int ai = 0; ai < 2; ++ai)
#pragma unroll
            for (int m = 0; m < 4; ++m) { bf16_t* rowp = O + (size_t)(row0 + ai * HALF + m * 16) * ldc + col0;
#pragma unroll
                for (int bj = 0; bj < 2; ++bj) { const f32x4 v0 = acc[ai][bj][m][0], v1 = acc[ai][bj][m][1];
                    u32x4 w; w.x = cvt_pk_bf16(v0[0], v0[1]); w.y = cvt_pk_bf16(v0[2], v0[3]); w.z = cvt_pk_bf16(v1[0], v1[1]); w.w = cvt_pk_bf16(v1[2], v1[3]);
                    *(u32x4*)(rowp + bj * HALF) = w; } }
    }
};
struct EpiGate {
    static constexpr bool PERM = true, AFTER_DRAIN = false;
    float* X; const float* gate;
    bf16_t* An; const float* gn; const float* sc; float* rowss; PG8_LAS float* red;
    __device__ __forceinline__ void operator()(const f32x4 (&acc)[2][2][4][2], const Unit& u, int wr, int wc, int fr, int fq) const {
        const int row0 = u.pm * BM + wr * 64 + fr, col0 = u.pn * BM + wc * 32 + 8 * fq;
        const int cond = (u.pm < 32) ? 8 : ((u.pm - 32) >> 4);
        const float* gp = gate + (size_t)cond * 12288 + col0;
        const bool nn = An != nullptr;
        float ssq[2][4];
#pragma unroll
        for (int ai = 0; ai < 2; ++ai)
#pragma unroll
            for (int m = 0; m < 4; ++m) ssq[ai][m] = 0.f;
#pragma unroll
        for (int bj = 0; bj < 2; ++bj) {
            const float* gnp = gn + col0 + bj * HALF; const float* scp = sc + (size_t)cond * 12288 + col0 + bj * HALF;
            const f32x4 g0 = *(const f32x4*)(gp + bj * HALF), g1 = *(const f32x4*)(gp + bj * HALF + 4);
            const f32x4 gn0 = *(const f32x4*)gnp, gn1 = *(const f32x4*)(gnp + 4), sc0 = *(const f32x4*)scp, sc1 = *(const f32x4*)(scp + 4);
            float* const colp0 = X + (size_t)row0 * 2048 + col0 + bj * HALF;
            f32x4 xv[4][2];
#pragma unroll
            for (int m = 0; m < 4; ++m) { xv[m][0] = *(const f32x4*)(colp0 + (size_t)(m * 16) * 2048); xv[m][1] = *(const f32x4*)(colp0 + (size_t)(m * 16) * 2048 + 4); }
            asm volatile("" ::: "memory");
            const f32x4 s0 = gn0 * (sc0 + 1.0f), s1 = gn1 * (sc1 + 1.0f);
#pragma unroll
            for (int ai = 0; ai < 2; ++ai) {
                float* colp = colp0 + (size_t)(ai * HALF) * 2048;
                if (ai == 1) {
#pragma unroll
                    for (int m = 0; m < 4; ++m) { xv[m][0] = *(const f32x4*)(colp + (size_t)(m * 16) * 2048); xv[m][1] = *(const f32x4*)(colp + (size_t)(m * 16) * 2048 + 4); } }
#pragma unroll
                for (int m = 0; m < 4; ++m) { const f32x4 a = xv[m][0] + g0 * acc[ai][bj][m][0], b = xv[m][1] + g1 * acc[ai][bj][m][1];
                    *(f32x4*)(colp + (size_t)(m * 16) * 2048) = a; *(f32x4*)(colp + (size_t)(m * 16) * 2048 + 4) = b;
                    if (nn) { ssq[ai][m] += ((a[0] * a[0] + a[1] * a[1]) + (a[2] * a[2] + a[3] * a[3])) + ((b[0] * b[0] + b[1] * b[1]) + (b[2] * b[2] + b[3] * b[3]));
                        const f32x4 ya = a * s0, yb = b * s1; u32x4 w; w.x = cvt_pk_bf16(ya[0], ya[1]); w.y = cvt_pk_bf16(ya[2], ya[3]); w.z = cvt_pk_bf16(yb[0], yb[1]); w.w = cvt_pk_bf16(yb[2], yb[3]);
                        *(u32x4*)(An + (size_t)(row0 + ai * HALF + m * 16) * 2048 + col0 + bj * HALF) = w; } }
                asm volatile("" ::: "memory"); } }
        if (nn) {
#pragma unroll
            for (int ai = 0; ai < 2; ++ai)
#pragma unroll
                for (int m = 0; m < 4; ++m) { float s = ssq[ai][m]; s += __shfl_xor(s, 16); s += __shfl_xor(s, 32);
                    if (fq == 0) red[(ai * HALF + wr * 64 + m * 16 + fr) * 4 + wc] = s; }
            asm volatile("s_waitcnt lgkmcnt(0)" ::: "memory"); __builtin_amdgcn_s_barrier(); asm volatile("" ::: "memory");
            const int t = (wr * 4 + wc) * 64 + fq * 16 + fr;
            if (t < 256) { const f32x4 pr = *(const PG8_LAS f32x4*)(red + t * 4); rowss[(size_t)(u.pm * BM + t) * 8 + u.pn] = (pr[0] + pr[1]) + (pr[2] + pr[3]); } }
    }
};
__device__ __forceinline__ float rstd_of(const float* s8) { const f32x4 a = *(const f32x4*)s8, b = *(const f32x4*)(s8 + 4); return 1.0f / sqrtf((((a[0] + a[1]) + (a[2] + a[3])) + ((b[0] + b[1]) + (b[2] + b[3]))) * (1.0f / 2048.0f) + 1e-6f); }

struct EpiConvGlu {
    static constexpr bool PERM = true, AFTER_DRAIN = false;
    bf16_t* ACT; const float* cw; const float* cb; float* EDGE; PG8_LAS float* xg;
    const float* rowss; const float* shw;
    __device__ __forceinline__ void operator()(f32x4 (&acc)[2][2][4][2], const Unit& u, int wr, int wc, int fr, int fq) const {
        const int cl = wc * 32 + 8 * fq, f0 = u.pn * 128 + cl;
        { const int cond = (u.pm < 32) ? 8 : ((u.pm - 32) >> 4);
          const float* sp = shw + (size_t)cond * 11264 + u.pn * BM + cl;
          { const int t = (wr * 4 + wc) * 64 + fq * 16 + fr;
            if (t < 256) xg[256 + t] = rstd_of(rowss + (size_t)(u.pm * BM + t) * 8);
            asm volatile("s_waitcnt lgkmcnt(0)" ::: "memory"); __builtin_amdgcn_s_barrier(); asm volatile("" ::: "memory"); }
          float rs[8];
          { const f32x4 r0 = *(const PG8_LAS f32x4*)(xg + 256 + 8 * (16 * wr + fr)), r1 = *(const PG8_LAS f32x4*)(xg + 256 + 8 * (16 * wr + fr) + 4);
            rs[0] = r0[0]; rs[1] = r0[1]; rs[2] = r0[2]; rs[3] = r0[3]; rs[4] = r1[0]; rs[5] = r1[1]; rs[6] = r1[2]; rs[7] = r1[3]; }
#pragma unroll
          for (int bj = 0; bj < 2; ++bj)
#pragma unroll
              for (int n = 0; n < 2; ++n) { const f32x4 sh = *(const f32x4*)(sp + bj * HALF + 4 * n);
#pragma unroll
                  for (int ai = 0; ai < 2; ++ai)
#pragma unroll
                      for (int m = 0; m < 4; ++m) acc[ai][bj][m][n] = acc[ai][bj][m][n] * rs[4 * ai + m] + sh; } }
        if (wr == 1 && fr == 0)  { *(PG8_LAS f32x4*)(xg + cl) = acc[0][0][0][0]; *(PG8_LAS f32x4*)(xg + cl + 4) = acc[0][0][0][1]; }
        if (wr == 0 && fr == 15) { *(PG8_LAS f32x4*)(xg + 128 + cl) = acc[1][0][3][0]; *(PG8_LAS f32x4*)(xg + 128 + cl + 4) = acc[1][0][3][1]; }
        asm volatile("s_waitcnt lgkmcnt(0)" ::: "memory"); __builtin_amdgcn_s_barrier(); asm volatile("" ::: "memory");
        f32x4 w0[2], w1[2], w2[2], bb[2], prv[2], nxt[2];
#pragma unroll
        for (int n = 0; n < 2; ++n) { w0[n] = *(const f32x4*)(cw + f0 + 4 * n); w1[n] = *(const f32x4*)(cw + 5632 + f0 + 4 * n); w2[n] = *(const f32x4*)(cw + 2 * 5632 + f0 + 4 * n); bb[n] = *(const f32x4*)(cb + f0 + 4 * n); }
#pragma unroll
        for (int n = 0; n < 2; ++n)
#pragma unroll
            for (int j = 0; j < 4; ++j) {
                const float up_ = acc[1][0][3][n][j], dn_ = acc[0][0][0][n][j];
                prv[n][j] = __int_as_float(__builtin_amdgcn_update_dpp(0, __float_as_int(up_), 0x111, 0xf, 0xf, false));
                nxt[n][j] = __int_as_float(__builtin_amdgcn_update_dpp(0, __float_as_int(dn_), 0x101, 0xf, 0xf, false)); }
        if (fr == 0) {
#pragma unroll
            for (int n = 0; n < 2; ++n) prv[n] = (wr == 1) ? *(const PG8_LAS f32x4*)(xg + 128 + cl + 4 * n) : (f32x4){0.f, 0.f, 0.f, 0.f}; }
        if (fr == 15) {
#pragma unroll
            for (int n = 0; n < 2; ++n) nxt[n] = (wr == 0) ? *(const PG8_LAS f32x4*)(xg + cl + 4 * n) : (f32x4){0.f, 0.f, 0.f, 0.f}; }
        float* eb = EDGE + (size_t)u.pm * 6 * 5632 + f0;
        if (wr == 1 && fr == 15) {
#pragma unroll
            for (int n = 0; n < 2; ++n) { *(f32x4*)(eb + 0 * 5632 + 4 * n) = acc[1][0][2][n]; *(f32x4*)(eb + 1 * 5632 + 4 * n) = acc[1][0][3][n]; *(f32x4*)(eb + 2 * 5632 + 4 * n) = acc[1][1][3][n]; } }
        if (wr == 0 && fr == 0) {
#pragma unroll
            for (int n = 0; n < 2; ++n) { *(f32x4*)(eb + 3 * 5632 + 4 * n) = acc[0][0][0][n]; *(f32x4*)(eb + 4 * 5632 + 4 * n) = acc[0][0][1][n]; *(f32x4*)(eb + 5 * 5632 + 4 * n) = acc[0][1][0][n]; } }
        bf16_t* op = ACT + (size_t)(u.pm * BM + 8 * (16 * wr + fr)) * 5632 + f0;
#pragma unroll
        for (int tau = 0; tau < 8; ++tau) {
            unsigned w[4];
#pragma unroll
            for (int n = 0; n < 2; ++n) {
                const int tm = tau == 0 ? 0 : tau - 1, tp = tau == 7 ? 7 : tau + 1;
                const f32x4 xm = (tau == 0) ? prv[n] : acc[tm >> 2][0][tm & 3][n];
                const f32x4 xc = acc[tau >> 2][0][tau & 3][n];
                const f32x4 xp = (tau == 7) ? nxt[n] : acc[tp >> 2][0][tp & 3][n];
                const f32x4 vv = acc[tau >> 2][1][tau & 3][n];
                const f32x4 s = __builtin_elementwise_fma(w2[n], xp, __builtin_elementwise_fma(w1[n], xc, __builtin_elementwise_fma(w0[n], xm, bb[n])));
                const f32x4 tq = s * -1.4426950408889634f;
                f32x4 e4; e4[0] = __builtin_amdgcn_exp2f(tq[0]); e4[1] = __builtin_amdgcn_exp2f(tq[1]); e4[2] = __builtin_amdgcn_exp2f(tq[2]); e4[3] = __builtin_amdgcn_exp2f(tq[3]);
                const f32x4 d4 = e4 + 1.0f;
                f32x4 r4; r4[0] = __builtin_amdgcn_rcpf(d4[0]); r4[1] = __builtin_amdgcn_rcpf(d4[1]); r4[2] = __builtin_amdgcn_rcpf(d4[2]); r4[3] = __builtin_amdgcn_rcpf(d4[3]);
                const f32x4 a = (s * vv) * r4;
                w[2 * n] = cvt_pk_bf16(a[0], a[1]); w[2 * n + 1] = cvt_pk_bf16(a[2], a[3]);
            }
            u32x4 o; o.x = w[0]; o.y = w[1]; o.z = w[2]; o.w = w[3];
            *(u32x4*)(op + (size_t)tau * 5632) = o;
        }
    }
};

__host__ __device__ __forceinline__ int qk_row_of_dim(int d) { const int i = d & 31; return 32 * (2 * (d >> 6) + (i >> 4)) + 8 * ((i >> 2) & 3) + 4 * ((d >> 5) & 1) + (d & 3); }
struct EpiQKV {
    static constexpr bool PERM = true, AFTER_DRAIN = false;
    bf16_t* O; int ldc, nqk;
    const float* gq; const float* gk; const float* tab;
    float* SK; float* SV; int kvw, jl;
    PG8_LAS float* red;
    const float* rowss; const float* shw;
    __device__ __forceinline__ void operator()(f32x4 (&acc)[2][2][4][2], const Unit& u, int wr, int wc, int fr, int fq) const {
        typedef unsigned u32x2v __attribute__((ext_vector_type(2)));
        const int v0 = 2 * u.pn; const bool ctx = u.pm < 32;
        { const int cond = ctx ? 8 : ((u.pm - 32) >> 4);
          const float* sp = shw + (size_t)cond * ldc + u.pn * BM + wc * 32 + 8 * fq;
          { const int t = (wr * 4 + wc) * 64 + fq * 16 + fr;
            if (t < 256) red[2560 + t] = rstd_of(rowss + (size_t)(u.pm * BM + t) * 8);
            asm volatile("s_waitcnt lgkmcnt(0)" ::: "memory"); __builtin_amdgcn_s_barrier(); asm volatile("" ::: "memory"); }
          float rs[2][4];
#pragma unroll
          for (int ai = 0; ai < 2; ++ai)
#pragma unroll
              for (int m = 0; m < 4; ++m) rs[ai][m] = red[2560 + ai * HALF + wr * 64 + m * 16 + fr];
#pragma unroll
          for (int bj = 0; bj < 2; ++bj)
#pragma unroll
              for (int n = 0; n < 2; ++n) { const f32x4 sh = *(const f32x4*)(sp + bj * HALF + 4 * n);
#pragma unroll
                  for (int ai = 0; ai < 2; ++ai)
#pragma unroll
                      for (int m = 0; m < 4; ++m) acc[ai][bj][m][n] = acc[ai][bj][m][n] * rs[ai][m] + sh; } }
        const bool qk0 = v0 < nqk, qk1 = v0 + 1 < nqk;
        if (qk0 || qk1) {
#pragma unroll
            for (int bj = 0; bj < 2; ++bj) if (bj ? qk1 : qk0) {
#pragma unroll
                for (int ai = 0; ai < 2; ++ai)
#pragma unroll
                    for (int m = 0; m < 4; ++m) { const f32x4 a = acc[ai][bj][m][0], b = acc[ai][bj][m][1];
                        float s = (a[0] * a[0] + a[1] * a[1]) + (a[2] * a[2] + a[3] * a[3]) + (b[0] * b[0] + b[1] * b[1]) + (b[2] * b[2] + b[3] * b[3]);
                        s += __shfl_xor(s, 16); s += __shfl_xor(s, 32);
                        if (fq == 0) red[((ai * HALF + wr * 64 + m * 16 + fr) * 2 + bj) * 4 + wc] = s; } }
            asm volatile("s_waitcnt lgkmcnt(0)" ::: "memory"); __builtin_amdgcn_s_barrier(); asm volatile("" ::: "memory");
            { const int t = (wr * 4 + wc) * 64 + fq * 16 + fr;
              const f32x4 pr = *(const PG8_LAS f32x4*)(red + t * 4);
              red[2048 + t] = 1.0f / sqrtf(((pr[0] + pr[1]) + (pr[2] + pr[3])) * (1.0f / 128.0f) + 1e-6f); }
            asm volatile("s_waitcnt lgkmcnt(0)" ::: "memory"); __builtin_amdgcn_s_barrier(); asm volatile("" ::: "memory");
        }
        const int d1 = 64 * (wc >> 1) + 16 * (wc & 1) + 4 * fq, i0 = 16 * (wc & 1) + 4 * fq, tr0 = wr * 64 + fr;
        const unsigned ldb = (unsigned)ldc * 2u, kvb = (unsigned)kvw * 4u;
        const unsigned srow0 = (unsigned)((u.pm * 2 + jl) * 256 + tr0);
#pragma unroll
        for (int bj = 0; bj < 2; ++bj) {
            const int vec = v0 + bj;
            if (bj ? qk1 : qk0) {
                const float* g = vec < 16 ? gq : gk;
                const f32x4 g1 = *(const f32x4*)(g + d1), g2 = *(const f32x4*)(g + d1 + 32);
                const unsigned ob = (unsigned)(u.pm * BM + tr0) * ldb + (unsigned)(vec * 128 + d1) * 2u;
                const unsigned sb = srow0 * kvb + (unsigned)((vec - 16) * 128 + d1) * 4u;
#pragma unroll
                for (int ai = 0; ai < 2; ++ai)
#pragma unroll
                    for (int m = 0; m < 4; ++m) { const int dr = ai * HALF + m * 16;
                        const float rstd = red[2048 + (tr0 + dr) * 2 + bj];
                        f32x4 x1 = acc[ai][bj][m][0] * rstd * g1, x2 = acc[ai][bj][m][1] * rstd * g2;
                        if (!ctx) { const int p = (wc >> 1) ? (16 * m + fr) : (((u.pm - 32) * 4 + 2 * ai + wr) & 63);
                            const f32x4 c = *(const f32x4*)(tab + (unsigned)(p * 64 + i0)), s = *(const f32x4*)(tab + (unsigned)(p * 64 + 32 + i0));
                            const f32x4 y1 = x1 * c - x2 * s, y2 = x2 * c + x1 * s; x1 = y1; x2 = y2; }
                        u32x2v w1, w2; w1.x = cvt_pk_bf16(x1[0], x1[1]); w1.y = cvt_pk_bf16(x1[2], x1[3]); w2.x = cvt_pk_bf16(x2[0], x2[1]); w2.y = cvt_pk_bf16(x2[2], x2[3]);
                        char* op = (char*)O + (size_t)(ob + (unsigned)dr * ldb);
                        *(u32x2v*)op = w1; *(u32x2v*)(op + 64) = w2;
                        if (ctx && vec >= 16) { char* sp = (char*)SK + (size_t)(sb + (unsigned)dr * kvb); *(f32x4*)sp = x1; *(f32x4*)(sp + 128) = x2; }
                        if (m & 1) asm volatile("" ::: "memory");
                    }
            } else {
                const int cl = wc * 32 + 8 * fq;
                const unsigned ob = (unsigned)(u.pm * BM + tr0) * ldb + (unsigned)(vec * 128 + cl) * 2u;
                const unsigned sb = srow0 * kvb + (unsigned)((vec - nqk) * 128 + cl) * 4u;
#pragma unroll
                for (int ai = 0; ai < 2; ++ai)
#pragma unroll
                    for (int m = 0; m < 4; ++m) { const int dr = ai * HALF + m * 16; const f32x4 a = acc[ai][bj][m][0], b = acc[ai][bj][m][1];
                        u32x4 w; w.x = cvt_pk_bf16(a[0], a[1]); w.y = cvt_pk_bf16(a[2], a[3]); w.z = cvt_pk_bf16(b[0], b[1]); w.w = cvt_pk_bf16(b[2], b[3]);
                        *(u32x4*)((char*)O + (size_t)(ob + (unsigned)dr * ldb)) = w;
                        if (ctx) { char* sp = (char*)SV + (size_t)(sb + (unsigned)dr * kvb); *(f32x4*)sp = a; *(f32x4*)(sp + 16) = b; }
                    }
            }
        }
    }
};

template <class Epi, class Sched, bool ALIGN_EPI = false, bool SP2 = false, bool ROWPERM = false  >
__device__ __forceinline__ void gemm_phase(PG8_LAS unsigned char* lds, const Gemm g, const Sched& S, const Epi& E, const int wave_id  ) {
    int tid_ = (wave_id << 6) | (int)__builtin_amdgcn_mbcnt_hi(~0u, __builtin_amdgcn_mbcnt_lo(~0u, 0u)); asm volatile("" : "+v"(tid_));
    const int tid = tid_, wid = __builtin_amdgcn_readfirstlane(tid >> 6), lane = tid & 63, wr = wid >> 2, wc = wid & 3, fr = lane & 15, fq = lane >> 4;
    const int K = g.K, nt = K / BK;
    unsigned voffA[2], voffB[2];
#pragma unroll
    for (int i = 0; i < 2; ++i) { int R, C; stage_rc(tid * 16 + i * 8192, R, C); const int Rb = Epi::PERM ? ((R & ~31) + perm32(R & 31)) : R;
        const int Ra = ROWPERM ? (8 * (16 * (R >> 6) + (R & 15)) + ((R >> 4) & 3)) : R;
        voffA[i] = (unsigned)(Ra * K + C) * 2u; voffB[i] = (unsigned)(Rb * K + C) * 2u; }
    const size_t kstep = (size_t)(BK * 2);
    const size_t hstep = (size_t)HALF * K * 2;
    const size_t tstep = 2 * hstep;
    const size_t hstepA = ROWPERM ? (size_t)4 * K * 2 : hstep;
    const unsigned ldsw = (unsigned)wid * 1024u;
    const int aoff = lds_byte(wr * 64 + fr, fq * 8), boff = lds_byte(wc * 32 + fr, fq * 8);
#define PG8_SA(b, h) (((b) * 2 + (h)) * HTB)
#define PG8_SB(b, h) ((4 + (b) * 2 + (h)) * HTB)
#define PG8_STAGE(bufoff, gbase, voff) do { _Pragma("unroll") for (int _i = 0; _i < 2; ++_i) \
        __builtin_amdgcn_global_load_lds((const unsigned*)((const char*)(gbase) + (voff)[_i]), (PG8_LAS unsigned*)(lds + (bufoff) + ldsw + _i * 8192), 16, 0, 0); } while (0)
#define PG8_LDA(dst, b, h) do { _Pragma("unroll") for (int m = 0; m < 4; ++m) _Pragma("unroll") for (int k = 0; k < 2; ++k) dst[m][k] = *(const PG8_LAS bf16x8*)(lds + PG8_SA(b, h) + aoff + m * 2048 + k * 1024); } while (0)
#define PG8_LDB(dst, b, h) do { _Pragma("unroll") for (int n = 0; n < 2; ++n) _Pragma("unroll") for (int k = 0; k < 2; ++k) dst[n][k] = *(const PG8_LAS bf16x8*)(lds + PG8_SB(b, h) + boff + n * 2048 + k * 1024); } while (0)
#define PG8_MMA(ai, bj, At, Bt) do { __builtin_amdgcn_s_setprio(1); _Pragma("unroll") for (int m = 0; m < 4; ++m) _Pragma("unroll") for (int n = 0; n < 2; ++n) _Pragma("unroll") for (int k = 0; k < 2; ++k) \
        acc[ai][bj][m][n] = __builtin_amdgcn_mfma_f32_16x16x32_bf16(Bt[n][k], At[m][k], acc[ai][bj][m][n], 0, 0, 0); __builtin_amdgcn_s_setprio(0); } while (0)
#define PG8_WAIT_V(n) asm volatile("s_waitcnt vmcnt(" #n ")" ::: "memory")
#define PG8_WAIT_L(n) asm volatile("s_waitcnt lgkmcnt(" #n ")" ::: "memory")
#define PG8_BAR __builtin_amdgcn_s_barrier()
#define PG8_SCHED __builtin_amdgcn_sched_barrier(0)
    Unit cur, nxt; int ui = 0;
    if (!S.next(0, cur)) return;
    f32x4 acc[2][2][4][2];
#pragma unroll
    for (int a = 0; a < 2; ++a)
#pragma unroll
        for (int b = 0; b < 2; ++b)
#pragma unroll
            for (int m = 0; m < 4; ++m)
#pragma unroll
                for (int n = 0; n < 2; ++n) acc[a][b][m][n] = (f32x4){0.f, 0.f, 0.f, 0.f};
    bf16x8 At[4][2], B0[2][2], B1[2][2];
    const char* cA = (const char*)g.A + (size_t)cur.pm * tstep; const char* cB = (const char*)g.Bt + (size_t)cur.pn * tstep;
    S.a_ready(cur);
    if constexpr (SP2) {
        PG8_STAGE(PG8_SB(0, 0), cB, voffB); PG8_STAGE(PG8_SB(0, 1), cB + hstep, voffB); PG8_STAGE(PG8_SA(0, 0), cA, voffA); PG8_STAGE(PG8_SA(0, 1), cA + hstepA, voffA);
        if (wr == 1) PG8_BAR;
        PG8_WAIT_V(2); PG8_BAR;
        PG8_STAGE(PG8_SB(1, 0), cB + kstep, voffB); PG8_STAGE(PG8_SA(1, 0), cA + kstep, voffA); PG8_STAGE(PG8_SB(1, 1), cB + hstep + kstep, voffB);
        PG8_WAIT_V(6); PG8_BAR;
    } else {
        PG8_STAGE(PG8_SB(0, 0), cB, voffB); PG8_STAGE(PG8_SA(0, 0), cA, voffA); PG8_STAGE(PG8_SB(0, 1), cB + hstep, voffB); PG8_STAGE(PG8_SA(0, 1), cA + hstepA, voffA);
        if (wr == 1) PG8_BAR;
        PG8_WAIT_V(4); PG8_BAR;
        PG8_STAGE(PG8_SB(1, 0), cB + kstep, voffB); PG8_STAGE(PG8_SA(1, 0), cA + kstep, voffA); PG8_STAGE(PG8_SB(1, 1), cB + hstep + kstep, voffB);
        PG8_WAIT_V(6); PG8_BAR;
    }
    for (;;) {
        const bool has_next = S.next(ui + 1, nxt);
        const char* nA = has_next ? (const char*)g.A + (size_t)nxt.pm * tstep : cA; const char* nB = has_next ? (const char*)g.Bt + (size_t)nxt.pn * tstep : cB;
        for (int t = 0; t < nt; t += 2) {
            const bool last = (t == nt - 2);
            const char* a1 = cA + (size_t)(t + 1) * kstep;
            const char* a2 = last ? nA : cA + (size_t)(t + 2) * kstep; const char* b2 = last ? nB : cB + (size_t)(t + 2) * kstep;
            const char* a3 = a2 + kstep; const char* b3 = b2 + kstep;
            if (last && has_next) S.a_ready(nxt);
            if constexpr (SP2) {
            PG8_LDB(B0, 0, 0); PG8_LDB(B1, 0, 1); PG8_SCHED; PG8_LDA(At, 0, 0); PG8_STAGE(PG8_SA(1, 1), a1 + hstepA, voffA);
            PG8_WAIT_V(8); PG8_WAIT_L(0); PG8_BAR; PG8_MMA(0, 0, At, B0); PG8_MMA(0, 1, At, B1); PG8_BAR; PG8_SCHED;
            PG8_LDA(At, 0, 1); PG8_STAGE(PG8_SB(0, 0), b2, voffB); PG8_STAGE(PG8_SB(0, 1), b2 + hstep, voffB); PG8_STAGE(PG8_SA(0, 0), a2, voffA);
            PG8_WAIT_V(8); PG8_WAIT_L(0); PG8_BAR; PG8_MMA(1, 0, At, B0); PG8_MMA(1, 1, At, B1); PG8_BAR; PG8_SCHED;
            PG8_LDB(B0, 1, 0); PG8_LDB(B1, 1, 1); PG8_SCHED; PG8_LDA(At, 1, 0); PG8_STAGE(PG8_SA(0, 1), a2 + hstepA, voffA);
            PG8_WAIT_V(8); PG8_WAIT_L(0); PG8_BAR; PG8_MMA(0, 0, At, B0); PG8_MMA(0, 1, At, B1); PG8_BAR; PG8_SCHED;
            PG8_LDA(At, 1, 1); PG8_STAGE(PG8_SB(1, 0), b3, voffB); PG8_STAGE(PG8_SB(1, 1), b3 + hstep, voffB); PG8_STAGE(PG8_SA(1, 0), a3, voffA);
            PG8_WAIT_V(8); PG8_WAIT_L(0); PG8_BAR; PG8_MMA(1, 0, At, B0); PG8_MMA(1, 1, At, B1); PG8_BAR; PG8_SCHED;
            } else {
            PG8_LDB(B0, 0, 0); PG8_SCHED; PG8_LDA(At, 0, 0); PG8_STAGE(PG8_SA(1, 1), a1 + hstepA, voffA);
            PG8_WAIT_L(8); PG8_BAR; PG8_WAIT_L(0); PG8_MMA(0, 0, At, B0); PG8_BAR; PG8_SCHED;
            PG8_LDB(B1, 0, 1); PG8_STAGE(PG8_SB(0, 0), b2, voffB);
            PG8_BAR; PG8_WAIT_L(0); PG8_MMA(0, 1, At, B1); PG8_BAR;
            PG8_LDA(At, 0, 1); PG8_STAGE(PG8_SA(0, 0), a2, voffA);
            PG8_BAR; PG8_WAIT_L(0); PG8_MMA(1, 0, At, B0); PG8_BAR; PG8_SCHED;
            PG8_STAGE(PG8_SB(0, 1), b2 + hstep, voffB);
            PG8_WAIT_V(6); PG8_BAR; PG8_MMA(1, 1, At, B1); PG8_BAR;
            PG8_LDB(B0, 1, 0); PG8_SCHED; PG8_LDA(At, 1, 0); PG8_STAGE(PG8_SA(0, 1), a2 + hstepA, voffA);
            PG8_WAIT_L(8); PG8_BAR; PG8_WAIT_L(0); PG8_MMA(0, 0, At, B0); PG8_BAR; PG8_SCHED;
            PG8_LDB(B1, 1, 1); PG8_STAGE(PG8_SB(1, 0), b3, voffB);
            PG8_BAR; PG8_WAIT_L(0); PG8_MMA(0, 1, At, B1); PG8_BAR;
            PG8_LDA(At, 1, 1); PG8_STAGE(PG8_SA(1, 0), a3, voffA);
            PG8_BAR; PG8_WAIT_L(0); PG8_MMA(1, 0, At, B0); PG8_BAR; PG8_SCHED;
            PG8_STAGE(PG8_SB(1, 1), b3 + hstep, voffB);
            PG8_WAIT_V(6); PG8_BAR; PG8_MMA(1, 1, At, B1); PG8_BAR;
            }
        }
        if constexpr (ALIGN_EPI) { if (wr == 0) PG8_BAR; }
        if constexpr (!Epi::AFTER_DRAIN) { E(acc, cur, wr, wc, fr, fq); S.done(cur); }
        if (!has_next) break;
#pragma unroll
        for (int a = 0; a < 2; ++a)
#pragma unroll
            for (int b = 0; b < 2; ++b)
#pragma unroll
                for (int m = 0; m < 4; ++m)
#pragma unroll
                    for (int n = 0; n < 2; ++n) acc[a][b][m][n] = (f32x4){0.f, 0.f, 0.f, 0.f};
        cur = nxt; cA = nA; cB = nB; ++ui;
        if constexpr (ALIGN_EPI) { if (wr == 1) PG8_BAR; }
    }
    PG8_WAIT_V(0);
    if constexpr (!ALIGN_EPI) { if (wr == 0) PG8_BAR; }
    PG8_BAR;
    if constexpr (Epi::AFTER_DRAIN) { E.fused(acc, cur, wr, wc, fr, fq, lds, wid, lane); S.done(cur); }
#undef PG8_SA
#undef PG8_SB
#undef PG8_STAGE
#undef PG8_LDA
#undef PG8_LDB
#undef PG8_MMA
#undef PG8_WAIT_V
#undef PG8_WAIT_L
#undef PG8_BAR
#undef PG8_SCHED
}
}
namespace att {
typedef unsigned short bf16_t;
typedef short bf16x8 __attribute__((ext_vector_type(8)));
typedef short s16x4 __attribute__((ext_vector_type(4)));
typedef float f32x16 __attribute__((ext_vector_type(16)));
typedef unsigned u32x4 __attribute__((ext_vector_type(4)));
constexpr int D = 128, NW = 8, QBLK = 32, KVBLK = 64;
constexpr float SCALE = 0.088388347648318440f;
constexpr float THR = 8.f;
constexpr int NBUF = 3;
constexpr size_t SHM_V = KVBLK * D * 2, SHM_K = KVBLK * D * 2, SHM_ATTN = NBUF * SHM_V + NBUF * SHM_K + NW * 64 * 4;
#define ATT_KSWZ(row, colB) ((row) * 256 + ((colB) ^ (((row) & 7) << 4)))
#define ATT_SBAR() __builtin_amdgcn_sched_barrier(0)
__device__ __forceinline__ int crow(int r, int hi) { return (r & 3) + 8 * (r >> 2) + 4 * hi; }
__device__ __forceinline__ unsigned cvtpk(float lo, float hi) { unsigned r; asm volatile("v_cvt_pk_bf16_f32 %0, %1, %2" : "=v"(r) : "v"(lo), "v"(hi)); return r; }
__device__ __forceinline__ bf16x8 ld8(const bf16_t* p) { return *reinterpret_cast<const bf16x8*>(p); }

constexpr bool NOMAX = true;
__device__ __forceinline__ void partialSM(f32x16& p0, f32x16& p1, float& m_reg, float& mn, float& alpha) {
  constexpr float C = SCALE * 1.4426950408889634f;
  if (NOMAX) { alpha = 1.f; mn = m_reg; const float mC = -m_reg * C;
    __builtin_amdgcn_sched_barrier(0);
#pragma unroll
    for (int r = 0; r < 16; ++r) p0[r] = fmaf(p0[r], C, mC);
#pragma unroll
    for (int r = 0; r < 16; ++r) p1[r] = fmaf(p1[r], C, mC);
#pragma unroll
    for (int r = 0; r < 16; ++r) p0[r] = __builtin_amdgcn_exp2f(p0[r]);
    return; }
  float pmax = p0[0];
#pragma unroll
  for (int r = 1; r < 16; ++r) pmax = fmaxf(pmax, p0[r]);
#pragma unroll
  for (int r = 0; r < 16; ++r) pmax = fmaxf(pmax, p1[r]);
  { auto rr = __builtin_amdgcn_permlane32_swap(__float_as_uint(pmax), __float_as_uint(pmax), false, false);
    pmax = fmaxf(__uint_as_float(rr[0]), __uint_as_float(rr[1])); }
  if (__builtin_expect(__all(pmax - m_reg <= THR / SCALE), 1)) { mn = m_reg; alpha = 1.f; }
  else { mn = fmaxf(m_reg, pmax); alpha = __builtin_amdgcn_exp2f((m_reg - mn) * C); m_reg = mn; }
  float mnC = -mn * C;
#pragma unroll
  for (int r = 0; r < 16; ++r) p0[r] = fmaf(p0[r], C, mnC);
#pragma unroll
  for (int r = 0; r < 16; ++r) p1[r] = fmaf(p1[r], C, mnC);
#pragma unroll
  for (int r = 0; r < 16; ++r) p0[r] = __builtin_amdgcn_exp2f(p0[r]);
}
__device__ __forceinline__ void finishSM(f32x16& p0, f32x16& p1, float alpha, float& l_reg, bf16x8& pa0, bf16x8& pa1, bf16x8& pa2, bf16x8& pa3) {
#pragma unroll
  for (int r = 0; r < 16; ++r) p1[r] = __builtin_amdgcn_exp2f(p1[r]);
  float ps = 0;
#pragma unroll
  for (int r = 0; r < 16; ++r) ps += p0[r];
#pragma unroll
  for (int r = 0; r < 16; ++r) ps += p1[r];
  { auto rr = __builtin_amdgcn_permlane32_swap(__float_as_uint(ps), __float_as_uint(ps), false, false);
    ps = __uint_as_float(rr[0]) + __uint_as_float(rr[1]); }
  l_reg = l_reg * alpha + ps;
#define ATT_PK4(P, BASE, OUT) do { unsigned a0 = cvtpk(P[BASE + 0], P[BASE + 1]), a1 = cvtpk(P[BASE + 2], P[BASE + 3]);   \
    unsigned b0 = cvtpk(P[BASE + 4], P[BASE + 5]), b1 = cvtpk(P[BASE + 6], P[BASE + 7]);                              \
    auto r0 = __builtin_amdgcn_permlane32_swap(a0, b0, false, false); auto r1 = __builtin_amdgcn_permlane32_swap(a1, b1, false, false); \
    u32x4 w = {r0[0], r1[0], r0[1], r1[1]}; OUT = *reinterpret_cast<bf16x8*>(&w); } while (0)
  ATT_PK4(p0, 0, pa0); ATT_PK4(p0, 8, pa1); ATT_PK4(p1, 0, pa2); ATT_PK4(p1, 8, pa3);
#undef ATT_PK4
}
__device__ __forceinline__ void qkt(f32x16& p0, f32x16& p1, const bf16_t* Ks, const bf16x8* qr, int r32, int hi) {
  p0 = f32x16{}; p1 = f32x16{};
#pragma unroll
  for (int d0 = 0; d0 < 8; ++d0) { int cb = (d0 * 16 + hi * 8) * 2;
    bf16x8 b0 = *reinterpret_cast<const bf16x8*>((const char*)Ks + ATT_KSWZ(r32, cb));
    bf16x8 b1 = *reinterpret_cast<const bf16x8*>((const char*)Ks + ATT_KSWZ(32 + r32, cb));
    p0 = __builtin_amdgcn_mfma_f32_32x32x16_bf16(b0, qr[d0], p0, 0, 0, 0);
    p1 = __builtin_amdgcn_mfma_f32_32x32x16_bf16(b1, qr[d0], p1, 0, 0, 0); }
}
__device__ __forceinline__ void band_mask(f32x16& p0, f32x16& p1, int qpos, int kbase, int hi) {
#pragma unroll
  for (int r = 0; r < 16; ++r) { const int d = kbase + crow(r, hi) - qpos;
    if ((unsigned)(d + 128) > 256u) p0[r] = -1e30f;
    if ((unsigned)(d + 160) > 256u) p1[r] = -1e30f; }
}
__device__ __forceinline__ int v_st(int k, int c) { const int kk = (k & ~0xC) | ((k & 4) << 1) | ((k & 8) >> 1); return ((kk >> 3) * 4 + (c >> 5)) * 512 + ((kk & 7) * 32 + (c & 31)) * 2; }
__device__ __forceinline__ int v_rd_base(int lane) { return ((lane & 3) << 3) | (((lane >> 2) & 3) << 6) | (((lane >> 4) & 1) << 5) | (((lane >> 5) & 1) << 8); }
constexpr int v_rd_off(int d0, int ks, int half) { return d0 * 512 + ks * 4096 + half * 2048; }
template <int OFF> __device__ __forceinline__ s16x4 tr_read(int vb) {
  s16x4 r; asm volatile("ds_read_b64_tr_b16 %0, %1 offset:%2" : "=&v"(r) : "v"(vb), "i"(OFF) : "memory"); return r;
}
template <int D0> __device__ __forceinline__ void pv_one(f32x16& od, int vb, bf16x8 pa0, bf16x8 pa1, bf16x8 pa2, bf16x8 pa3) {
  const s16x4 l0 = tr_read<v_rd_off(D0, 0, 0)>(vb), h0 = tr_read<v_rd_off(D0, 0, 1)>(vb), l1 = tr_read<v_rd_off(D0, 1, 0)>(vb), h1 = tr_read<v_rd_off(D0, 1, 1)>(vb);
  const s16x4 l2 = tr_read<v_rd_off(D0, 2, 0)>(vb), h2 = tr_read<v_rd_off(D0, 2, 1)>(vb), l3 = tr_read<v_rd_off(D0, 3, 0)>(vb), h3 = tr_read<v_rd_off(D0, 3, 1)>(vb);
  asm volatile("s_waitcnt lgkmcnt(0)" ::: "memory"); ATT_SBAR();
#define ATT_PK(L, H) (bf16x8){L[0], L[1], L[2], L[3], H[0], H[1], H[2], H[3]}
  od = __builtin_amdgcn_mfma_f32_32x32x16_bf16(pa0, ATT_PK(l0, h0), od, 0, 0, 0);
  od = __builtin_amdgcn_mfma_f32_32x32x16_bf16(pa1, ATT_PK(l1, h1), od, 0, 0, 0);
  od = __builtin_amdgcn_mfma_f32_32x32x16_bf16(pa2, ATT_PK(l2, h2), od, 0, 0, 0);
  od = __builtin_amdgcn_mfma_f32_32x32x16_bf16(pa3, ATT_PK(l3, h3), od, 0, 0, 0);
#undef ATT_PK
}
__device__ __forceinline__ void pv_d0(f32x16* o, int vb, bf16x8 pa0, bf16x8 pa1, bf16x8 pa2, bf16x8 pa3) {
  pv_one<0>(o[0], vb, pa0, pa1, pa2, pa3); pv_one<1>(o[1], vb, pa0, pa1, pa2, pa3); pv_one<2>(o[2], vb, pa0, pa1, pa2, pa3); pv_one<3>(o[3], vb, pa0, pa1, pa2, pa3);
}

struct Unit {
  const bf16_t* Q; int ldq;
  const bf16_t* K0; const bf16_t* V0; int ld0, n0;
  const bf16_t* K1; const bf16_t* V1; int ld1, n1;
  int mask, qpos0, kpos0;
  float m_init, l_init;
  bf16_t* O; int ldo;
};

__device__ __forceinline__ void attn_unit(const Unit& U, char* lds, const int wave_id) {
  int tid_ = (wave_id << 6) | (int)__builtin_amdgcn_mbcnt_hi(~0u, __builtin_amdgcn_mbcnt_lo(~0u, 0u)); asm volatile("" : "+v"(tid_));
  const int tid = tid_, wid = tid >> 6, lane = tid & 63, r32 = lane & 31, hi = lane >> 5;
  bf16_t* V_lds = (bf16_t*)lds; bf16_t* K_lds = (bf16_t*)(lds + NBUF * SHM_V);
  float* ws = (float*)(lds + NBUF * SHM_V + NBUF * SHM_K) + wid * 64; float* li_l = ws; float* al_l = ws + 32;
  float m_reg = U.m_init, l_reg = U.l_init; f32x16 o[4] = {}; bf16x8 qr[8];
  const bf16_t* Qw = U.Q + (long)(wid * QBLK + r32) * U.ldq + hi * 8;
#pragma unroll
  for (int d0 = 0; d0 < 8; ++d0) qr[d0] = ld8(Qw + d0 * 16);
  typedef const __attribute__((address_space(1))) bf16_t* gbf;
  __attribute__((address_space(3))) char* const ldsl = (__attribute__((address_space(3))) char*)lds;
  int rK0, rK1, cK0, cK1, rV0, rV1, cV0, cV1;
  { const int r0_ = 4 * (2 * wave_id) + (lane >> 4), r1_ = r0_ + 4; rK0 = r0_; rK1 = r1_; cK0 = ((lane & 15) ^ (r0_ & 7)) * 8; cK1 = ((lane & 15) ^ (r1_ & 7)) * 8;
    const int q0_ = 64 * (2 * wave_id) + lane, q1_ = q0_ + 64;
    { const int s_ = q0_ >> 5, t_ = q0_ & 31, kk_ = (s_ >> 2) * 8 + (t_ >> 2); rV0 = (kk_ & ~0xC) | ((kk_ & 4) << 1) | ((kk_ & 8) >> 1); cV0 = (s_ & 3) * 32 + (t_ & 3) * 8; }
    { const int s_ = q1_ >> 5, t_ = q1_ & 31, kk_ = (s_ >> 2) * 8 + (t_ >> 2); rV1 = (kk_ & ~0xC) | ((kk_ & 4) << 1) | ((kk_ & 8) >> 1); cV1 = (s_ & 3) * 32 + (t_ & 3) * 8; } }
  const int vb0 = (int)(uintptr_t)V_lds + v_rd_base(lane);
  const int qpos = U.qpos0 + wid * QBLK + r32, qlo = U.qpos0 + wid * QBLK;
#define ATT_STAGE(t, b) do { const int t_ = (t); gbf kp_; gbf vp_; long ld_;                                                             \
    if (t_ < U.n0) { ld_ = U.ld0; kp_ = (gbf)U.K0 + (long)t_ * KVBLK * ld_; vp_ = (gbf)U.V0 + (long)t_ * KVBLK * ld_; }                 \
    else { ld_ = U.ld1; kp_ = (gbf)U.K1 + (long)(t_ - U.n0) * KVBLK * ld_; vp_ = (gbf)U.V1 + (long)(t_ - U.n0) * KVBLK * ld_; }           \
    __attribute__((address_space(3))) char* kd_ = ldsl + NBUF * SHM_V + (b) * SHM_K + wave_id * 2048;                                    \
    __attribute__((address_space(3))) char* vd_ = ldsl + (b) * SHM_V + wave_id * 2048;                                                   \
    __builtin_amdgcn_global_load_lds((const __attribute__((address_space(1))) unsigned*)(kp_ + (long)rK0 * ld_ + cK0), (__attribute__((address_space(3))) unsigned*)kd_, 16, 0, 0);          \
    __builtin_amdgcn_global_load_lds((const __attribute__((address_space(1))) unsigned*)(kp_ + (long)rK1 * ld_ + cK1), (__attribute__((address_space(3))) unsigned*)(kd_ + 1024), 16, 0, 0);  \
    __builtin_amdgcn_global_load_lds((const __attribute__((address_space(1))) unsigned*)(vp_ + (long)rV0 * ld_ + cV0), (__attribute__((address_space(3))) unsigned*)vd_, 16, 0, 0);          \
    __builtin_amdgcn_global_load_lds((const __attribute__((address_space(1))) unsigned*)(vp_ + (long)rV1 * ld_ + cV1), (__attribute__((address_space(3))) unsigned*)(vd_ + 1024), 16, 0, 0); } while (0)
#define ATT_RESC(a) do { if (!NOMAX && __any((a) < 1.f)) { if (hi == 0) al_l[r32] = (a); asm volatile("s_waitcnt lgkmcnt(0)" ::: "memory"); \
    _Pragma("unroll") for (int d = 0; d < 4; ++d) _Pragma("unroll") for (int r = 0; r < 16; ++r) o[d][r] *= al_l[crow(r, hi)]; } } while (0)
#define ATT_MASK(P0, P1, t) do { const int t_ = (t); if (U.mask && t_ < U.n0) { const int kb_ = U.kpos0 + t_ * KVBLK;                  \
    if (kb_ + 63 - qlo > 128 || qlo + 31 - kb_ > 128) band_mask(P0, P1, qpos, kb_, hi); } } while (0)
  f32x16 pA0, pA1, pB0, pB1; float mnA, mnB, alA, alB; bf16x8 pa0, pa1, pa2, pa3; const int NT = U.n0 + U.n1, TL = NT - 1;
#define ATT_BAR() do { asm volatile("s_waitcnt lgkmcnt(0)" ::: "memory"); __builtin_amdgcn_s_barrier(); asm volatile("" ::: "memory"); } while (0)
#define ATT_HALF(P0, P1, MN, AL, Q0, Q1, MNQ, ALQ, jj) do {                                                                                \
    const int bn_ = (bcur == 2) ? 0 : bcur + 1;                                                                                            \
    ATT_SBAR(); qkt(Q0, Q1, (bf16_t*)((char*)K_lds + bn_ * SHM_K), qr, r32, hi);                                                          \
    finishSM(P0, P1, AL, l_reg, pa0, pa1, pa2, pa3); ATT_SBAR();                                                                           \
    pv_d0(o, vb0 + bcur * (int)SHM_V, pa0, pa1, pa2, pa3); ATT_MASK(Q0, Q1, (jj) + 1); partialSM(Q0, Q1, m_reg, MNQ, ALQ);                  \
    ATT_BAR();                                                                                                                             \
    if ((jj) + 3 < NT) { ATT_STAGE((jj) + 3, bcur); asm volatile("s_waitcnt vmcnt(4)" ::: "memory"); } else asm volatile("s_waitcnt vmcnt(0)" ::: "memory");  \
    ATT_RESC(ALQ); ATT_BAR();                                                                                                              \
    bcur = bn_; } while (0)
  ATT_STAGE(0, 0); ATT_STAGE(1, 1); ATT_STAGE(2, 2); asm volatile("s_waitcnt vmcnt(4)" ::: "memory"); ATT_BAR();
  qkt(pA0, pA1, K_lds, qr, r32, hi); ATT_MASK(pA0, pA1, 0); partialSM(pA0, pA1, m_reg, mnA, alA);
  int bcur = 0;
  for (int j = 0; j + 2 < NT; j += 2) {
    ATT_HALF(pA0, pA1, mnA, alA, pB0, pB1, mnB, alB, j);
    ATT_HALF(pB0, pB1, mnB, alB, pA0, pA1, mnA, alA, j + 1);
  }
  ATT_HALF(pA0, pA1, mnA, alA, pB0, pB1, mnB, alB, NT - 2);
  finishSM(pB0, pB1, alB, l_reg, pa0, pa1, pa2, pa3); ATT_SBAR();
  pv_d0(o, vb0 + bcur * (int)SHM_V, pa0, pa1, pa2, pa3);
#undef ATT_HALF
  if (hi == 0) li_l[r32] = l_reg; asm volatile("s_waitcnt lgkmcnt(0)" ::: "memory");
  float rli[16];
#pragma unroll
  for (int r = 0; r < 16; ++r) rli[r] = __builtin_amdgcn_rcpf(li_l[crow(r, hi)]);
  bf16_t* Ow = U.O + (long)(wid * QBLK) * U.ldo;
#pragma unroll
  for (int r = 0; r < 16; ++r) { const int orow = crow(r, hi);
#pragma unroll
    for (int d0 = 0; d0 < 4; d0 += 2) { const unsigned w = cvtpk(o[d0][r] * rli[r], o[d0 + 1][r] * rli[r]);
      Ow[(long)orow * U.ldo + d0 * 32 + r32] = (bf16_t)(w & 0xffffu); Ow[(long)orow * U.ldo + (d0 + 1) * 32 + r32] = (bf16_t)(w >> 16); } }
  asm volatile("s_waitcnt vmcnt(0)" ::: "memory"); ATT_BAR();
#undef ATT_BAR
#undef ATT_STAGE
#undef ATT_RESC
#undef ATT_MASK
}

constexpr int B_SHM_K = 64 * 128 * 2, B_SHM_V = 64 * 256 * 2, B_SHM_F = 8 * 2 * 64 * 16;
constexpr int B_OFF_K = 0, B_OFF_V = 2 * B_SHM_K, B_OFF_F = B_OFF_V + 2 * B_SHM_V, B_SHM_TOTAL = B_OFF_F + 2 * B_SHM_F;
struct UnitB {
  const bf16_t* Q; int ldq;
  const bf16_t* K0; const bf16_t* V0; int ld0, n0;
  const bf16_t* K1; const bf16_t* V1; int ld1, n1;
  float m_bound;
  bf16_t* O; int ldo;
  const float* subln; float lam, osc;
};
constexpr int vb_rd_off(int dd, int ks, int half) { return dd * 512 + ks * 8192 + half * 4096; }
template <int DD> __device__ __forceinline__ void pv_oneB(f32x16& od, int vb, bf16x8 pa0, bf16x8 pa1, bf16x8 pa2, bf16x8 pa3) {
  const s16x4 l0 = tr_read<vb_rd_off(DD, 0, 0)>(vb), h0 = tr_read<vb_rd_off(DD, 0, 1)>(vb), l1 = tr_read<vb_rd_off(DD, 1, 0)>(vb), h1 = tr_read<vb_rd_off(DD, 1, 1)>(vb);
  const s16x4 l2 = tr_read<vb_rd_off(DD, 2, 0)>(vb), h2 = tr_read<vb_rd_off(DD, 2, 1)>(vb), l3 = tr_read<vb_rd_off(DD, 3, 0)>(vb), h3 = tr_read<vb_rd_off(DD, 3, 1)>(vb);
  asm volatile("s_waitcnt lgkmcnt(0)" ::: "memory"); ATT_SBAR();
#define ATT_PK(L, H) (bf16x8){L[0], L[1], L[2], L[3], H[0], H[1], H[2], H[3]}
  od = __builtin_amdgcn_mfma_f32_32x32x16_bf16(pa0, ATT_PK(l0, h0), od, 0, 0, 0);
  od = __builtin_amdgcn_mfma_f32_32x32x16_bf16(pa1, ATT_PK(l1, h1), od, 0, 0, 0);
  od = __builtin_amdgcn_mfma_f32_32x32x16_bf16(pa2, ATT_PK(l2, h2), od, 0, 0, 0);
  od = __builtin_amdgcn_mfma_f32_32x32x16_bf16(pa3, ATT_PK(l3, h3), od, 0, 0, 0);
#undef ATT_PK
}
template <int DD> __device__ __forceinline__ void pv_issueB(s16x4 (&G)[8], int vb) {
  G[0] = tr_read<vb_rd_off(DD, 0, 0)>(vb); G[1] = tr_read<vb_rd_off(DD, 0, 1)>(vb); G[2] = tr_read<vb_rd_off(DD, 1, 0)>(vb); G[3] = tr_read<vb_rd_off(DD, 1, 1)>(vb);
  G[4] = tr_read<vb_rd_off(DD, 2, 0)>(vb); G[5] = tr_read<vb_rd_off(DD, 2, 1)>(vb); G[6] = tr_read<vb_rd_off(DD, 3, 0)>(vb); G[7] = tr_read<vb_rd_off(DD, 3, 1)>(vb);
}
__device__ __forceinline__ void pv_mmaB(f32x16& od, const s16x4 (&G)[8], bf16x8 pa0, bf16x8 pa1, bf16x8 pa2, bf16x8 pa3) {
#define ATT_PK(L, H) (bf16x8){L[0], L[1], L[2], L[3], H[0], H[1], H[2], H[3]}
  od = __builtin_amdgcn_mfma_f32_32x32x16_bf16(pa0, ATT_PK(G[0], G[1]), od, 0, 0, 0);
  od = __builtin_amdgcn_mfma_f32_32x32x16_bf16(pa1, ATT_PK(G[2], G[3]), od, 0, 0, 0);
  od = __builtin_amdgcn_mfma_f32_32x32x16_bf16(pa2, ATT_PK(G[4], G[5]), od, 0, 0, 0);
  od = __builtin_amdgcn_mfma_f32_32x32x16_bf16(pa3, ATT_PK(G[6], G[7]), od, 0, 0, 0);
#undef ATT_PK
}
template <int C_> __device__ __forceinline__ void attb_pass(const UnitB& U, char* lds, const int wave_id, unsigned (&P0pk)[32]) {
  int tid_ = (wave_id << 6) | (int)__builtin_amdgcn_mbcnt_hi(~0u, __builtin_amdgcn_mbcnt_lo(~0u, 0u)); asm volatile("" : "+v"(tid_));
  const int tid = tid_, wid = wave_id, lane = tid & 63, r32 = lane & 31, hi = lane >> 5, rg = wid & 3, x = wid >> 2;
  char* K_lds = lds + B_OFF_K; char* V_lds = lds + B_OFF_V; char* F_lds = lds + B_OFF_F;
  constexpr float C = SCALE * 1.4426950408889634f;
  const float mC = -U.m_bound * C;
  const int srk = tid >> 4, sck = (tid & 15) * 8, srv = tid >> 5, scv = (tid & 31) * 8;
  const int kst0 = ATT_KSWZ(srk, sck * 2), kst1 = ATT_KSWZ(32 + srk, sck * 2);
  int vst0; { const int kk = (srv & ~0xC) | ((srv & 4) << 1) | ((srv & 8) >> 1); vst0 = ((kk >> 3) * 8 + (scv >> 5)) * 512 + ((kk & 7) * 32 + (scv & 31)) * 2; }
  const int vb0 = (int)(uintptr_t)V_lds + x * 2048 + v_rd_base(lane);
  char* const fw = F_lds + (wid * 2) * 1024 + lane * 16;
  const char* const fr_ = F_lds + (rg * 2) * 1024 + lane * 16;
  typedef const __attribute__((address_space(1))) bf16_t* gbf; typedef const __attribute__((address_space(1))) bf16x8* gbf8;
#define B_TILE(t, KP, VP, LD) gbf KP; gbf VP; long LD; { const int t_ = (t);                                                           \
    if (t_ < U.n0) { LD = U.ld0; KP = (gbf)U.K0 + coff + (long)t_ * KVBLK * LD; VP = (gbf)U.V0 + (long)t_ * KVBLK * LD; }              \
    else { LD = U.ld1; KP = (gbf)U.K1 + coff + (long)(t_ - U.n0) * KVBLK * LD; VP = (gbf)U.V1 + (long)(t_ - U.n0) * KVBLK * LD; } }
#define B_LD8(p) (*(gbf8)(p))
  __attribute__((address_space(3))) char* const ldsl = (__attribute__((address_space(3))) char*)lds;
  int rK0, rK1, cK0, cK1, rV[4], cV[4];
  { const int r0_ = 4 * (2 * wave_id) + (lane >> 4), r1_ = r0_ + 4; rK0 = r0_; rK1 = r1_; cK0 = ((lane & 15) ^ (r0_ & 7)) * 8; cK1 = ((lane & 15) ^ (r1_ & 7)) * 8;
#pragma unroll
    for (int i = 0; i < 4; ++i) { const int q_ = 64 * (4 * wave_id + i) + lane, s_ = q_ >> 5, t_ = q_ & 31, kk_ = (s_ >> 3) * 8 + (t_ >> 2);
      rV[i] = (kk_ & ~0xC) | ((kk_ & 4) << 1) | ((kk_ & 8) >> 1); cV[i] = (s_ & 7) * 32 + (t_ & 3) * 8; } }
#define B_DMAK(t, b) do { B_TILE(t, kp_, vp_, ld_); (void)vp_;                                                                             \
    __attribute__((address_space(3))) char* kd_ = ldsl + B_OFF_K + (b) * B_SHM_K + wave_id * 2048;                                          \
    __builtin_amdgcn_global_load_lds((const __attribute__((address_space(1))) unsigned*)(kp_ + (long)rK0 * ld_ + cK0), (__attribute__((address_space(3))) unsigned*)kd_, 16, 0, 0);          \
    __builtin_amdgcn_global_load_lds((const __attribute__((address_space(1))) unsigned*)(kp_ + (long)rK1 * ld_ + cK1), (__attribute__((address_space(3))) unsigned*)(kd_ + 1024), 16, 0, 0); } while (0)
#define B_DMAV(t, b) do { B_TILE(t, kp_, vp_, ld_); (void)kp_;                                                                             \
    __attribute__((address_space(3))) char* vd_ = ldsl + B_OFF_V + (b) * B_SHM_V + wave_id * 4096;                                          \
    _Pragma("unroll") for (int i_ = 0; i_ < 4; ++i_)                                                                                       \
      __builtin_amdgcn_global_load_lds((const __attribute__((address_space(1))) unsigned*)(vp_ + (long)rV[i_] * ld_ + cV[i_]), (__attribute__((address_space(3))) unsigned*)(vd_ + i_ * 1024), 16, 0, 0); } while (0)
#define B_END() do { asm volatile("s_waitcnt vmcnt(0)" ::: "memory"); __syncthreads(); } while (0)
#define B_LOADK(R, t) do { B_TILE(t, kp_, vp_, ld_); (void)vp_; R.k0 = B_LD8(kp_ + (long)srk * ld_ + sck); R.k1 = B_LD8(kp_ + (long)(32 + srk) * ld_ + sck); } while (0)
#define B_LOADV(R, t) do { B_TILE(t, kp_, vp_, ld_); (void)kp_; R.v0 = B_LD8(vp_ + (long)srv * ld_ + scv); R.v1 = B_LD8(vp_ + (long)(16 + srv) * ld_ + scv);     \
    R.v2 = B_LD8(vp_ + (long)(32 + srv) * ld_ + scv); R.v3 = B_LD8(vp_ + (long)(48 + srv) * ld_ + scv); } while (0)
#define B_WRITEK(b, R) do { *(bf16x8*)(K_lds + (b) * B_SHM_K + kst0) = R.k0; *(bf16x8*)(K_lds + (b) * B_SHM_K + kst1) = R.k1; } while (0)
#define B_WRITEV(b, R) do { *(bf16x8*)(V_lds + (b) * B_SHM_V + vst0) = R.v0; *(bf16x8*)(V_lds + (b) * B_SHM_V + vst0 + 8192) = R.v1;        \
    *(bf16x8*)(V_lds + (b) * B_SHM_V + vst0 + 16384) = R.v2; *(bf16x8*)(V_lds + (b) * B_SHM_V + vst0 + 24576) = R.v3; } while (0)
#define B_QK(b) do { bf16x8 kf[4];                                                                                                        \
    _Pragma("unroll") for (int d0 = 0; d0 < 4; ++d0) kf[d0] = *reinterpret_cast<const bf16x8*>(K_lds + (b) * B_SHM_K + ATT_KSWZ(32 * x + r32, (d0 * 16 + hi * 8) * 2)); \
    pS = f32x16{};                                                                                                                         \
    _Pragma("unroll") for (int d0 = 0; d0 < 8; ++d0) { pS = __builtin_amdgcn_mfma_f32_32x32x16_bf16(kf[d0 & 3], qr[d0], pS, 0, 0, 0);          \
      if (d0 + 4 < 8) kf[d0 & 3] = *reinterpret_cast<const bf16x8*>(K_lds + (b) * B_SHM_K + ATT_KSWZ(32 * x + r32, ((d0 + 4) * 16 + hi * 8) * 2)); } } while (0)
#define B_SM_EXP(lo) do { _Pragma("unroll") for (int r = (lo); r < (lo) + 8; r += 2) { const f32x2p t_ = (f32x2p){pS[r], pS[r + 1]} * C + mC2;     \
      pS[r] = __builtin_amdgcn_exp2f(t_[0]); pS[r + 1] = __builtin_amdgcn_exp2f(t_[1]); } } while (0)
#define B_SM_PUB(b) do { _Pragma("unroll") for (int r = 0; r < 16; r += 2) l2 += (f32x2p){pS[r], pS[r + 1]};                                     \
    bf16x8 fa, fb;                                                                                                                        \
    { unsigned a0 = cvtpk(pS[0], pS[1]), a1 = cvtpk(pS[2], pS[3]), b0 = cvtpk(pS[4], pS[5]), b1 = cvtpk(pS[6], pS[7]);                      \
      auto r0 = __builtin_amdgcn_permlane32_swap(a0, b0, false, false); auto r1 = __builtin_amdgcn_permlane32_swap(a1, b1, false, false);   \
      u32x4 w = {r0[0], r1[0], r0[1], r1[1]}; fa = *reinterpret_cast<bf16x8*>(&w); }                                                       \
    { unsigned a0 = cvtpk(pS[8], pS[9]), a1 = cvtpk(pS[10], pS[11]), b0 = cvtpk(pS[12], pS[13]), b1 = cvtpk(pS[14], pS[15]);                \
      auto r0 = __builtin_amdgcn_permlane32_swap(a0, b0, false, false); auto r1 = __builtin_amdgcn_permlane32_swap(a1, b1, false, false);   \
      u32x4 w = {r0[0], r1[0], r0[1], r1[1]}; fb = *reinterpret_cast<bf16x8*>(&w); }                                                       \
    *(bf16x8*)(fw + (b) * B_SHM_F) = fa; *(bf16x8*)(fw + (b) * B_SHM_F + 1024) = fb; } while (0)
#define B_PV_SM(bp, b) do {                                                                                                               \
    const bf16x8 pa0 = *(const bf16x8*)(fr_ + (bp) * B_SHM_F), pa1 = *(const bf16x8*)(fr_ + (bp) * B_SHM_F + 1024);                         \
    const bf16x8 pa2 = *(const bf16x8*)(fr_ + (bp) * B_SHM_F + 8192), pa3 = *(const bf16x8*)(fr_ + (bp) * B_SHM_F + 8192 + 1024);           \
    s16x4 G0[8], G1[8]; const int vb_ = vb0 + (bp) * B_SHM_V;                                                                               \
    ATT_SBAR(); pv_issueB<0>(G0, vb_); pv_issueB<1>(G1, vb_);                         \
    asm volatile("s_waitcnt lgkmcnt(8)" ::: "memory"); ATT_SBAR();                                 \
    pv_mmaB(o[0], G0, pa0, pa1, pa2, pa3); ATT_SBAR(); B_SM_EXP(0); pv_issueB<2>(G0, vb_);                                                   \
    asm volatile("s_waitcnt lgkmcnt(8)" ::: "memory"); ATT_SBAR();                                                                 \
    pv_mmaB(o[1], G1, pa0, pa1, pa2, pa3); ATT_SBAR(); B_SM_EXP(8); pv_issueB<3>(G1, vb_);                                                   \
    asm volatile("s_waitcnt lgkmcnt(8)" ::: "memory"); ATT_SBAR();                                                                 \
    pv_mmaB(o[2], G0, pa0, pa1, pa2, pa3); ATT_SBAR(); B_SM_PUB(b);                                                                          \
    asm volatile("s_waitcnt lgkmcnt(0)" ::: "memory"); ATT_SBAR();                                   \
    pv_mmaB(o[3], G1, pa0, pa1, pa2, pa3); } while (0)
#define B_PV(bp) do {                                                                                                                     \
    const bf16x8 pa0 = *(const bf16x8*)(fr_ + (bp) * B_SHM_F), pa1 = *(const bf16x8*)(fr_ + (bp) * B_SHM_F + 1024);                         \
    const bf16x8 pa2 = *(const bf16x8*)(fr_ + (bp) * B_SHM_F + 8192), pa3 = *(const bf16x8*)(fr_ + (bp) * B_SHM_F + 8192 + 1024);           \
    pv_oneB<0>(o[0], vb0 + (bp) * B_SHM_V, pa0, pa1, pa2, pa3); pv_oneB<1>(o[1], vb0 + (bp) * B_SHM_V, pa0, pa1, pa2, pa3);                 \
    pv_oneB<2>(o[2], vb0 + (bp) * B_SHM_V, pa0, pa1, pa2, pa3); pv_oneB<3>(o[3], vb0 + (bp) * B_SHM_V, pa0, pa1, pa2, pa3); } while (0)
  f32x16 pS;
  const int NT = U.n0 + U.n1;
  constexpr int c = C_; constexpr int coff = C_ * 128;
  typedef float f32x2p __attribute__((ext_vector_type(2)));
  f32x2p l2 = {0.f, 0.f}; const f32x2p mC2 = {mC, mC}; f32x16 o[4] = {}; bf16x8 qr[8];
  { const bf16_t* Qw = U.Q + coff + (long)(rg * QBLK + r32) * U.ldq + hi * 8;
#pragma unroll
    for (int d0 = 0; d0 < 8; ++d0) qr[d0] = ld8(Qw + d0 * 16); }
  B_DMAK(0, 0); B_END();
  B_DMAK(1, 1); B_DMAV(0, 0);
  B_QK(0); B_SM_EXP(0); B_SM_EXP(8); B_SM_PUB(0);
  B_END();
  for (int t = 1; t + 1 < NT; t += 2) {
    B_DMAK(t + 1, 0); B_DMAV(t, 1);
    ATT_SBAR(); B_QK(1); ATT_SBAR();
    B_PV_SM(0, 1);
    B_END();
    if (t + 2 < NT) B_DMAK(t + 2, 1);
    B_DMAV(t + 1, 0);
    ATT_SBAR(); B_QK(0); ATT_SBAR();
    B_PV_SM(1, 0);
    B_END();
  }
  B_DMAV(NT - 1, 1);
  ATT_SBAR(); B_QK(1); ATT_SBAR();
  B_PV_SM(0, 1);
  B_END();
  B_PV(1);
  __syncthreads();
  float* L = (float*)F_lds;
  { const float l_reg = l2[0] + l2[1];
    auto rr = __builtin_amdgcn_permlane32_swap(__float_as_uint(l_reg), __float_as_uint(l_reg), false, false);
    const float lw = __uint_as_float(rr[0]) + __uint_as_float(rr[1]);
    if (hi == 0) L[wid * 32 + r32] = lw; }
  __syncthreads();
  float rli[16];
#pragma unroll
  for (int r = 0; r < 16; ++r) { const int row = crow(r, hi); rli[r] = __builtin_amdgcn_rcpf(L[rg * 32 + row] + L[(rg + 4) * 32 + row]); }
  if (c == 0) {
#pragma unroll
    for (int r = 0; r < 16; ++r) { P0pk[r] = cvtpk(o[0][r] * rli[r], o[1][r] * rli[r]); P0pk[16 + r] = cvtpk(o[2][r] * rli[r], o[3][r] * rli[r]); }
  } else {
    float ssq[16];
#pragma unroll
    for (int r = 0; r < 16; ++r) { ssq[r] = 0.f;
#pragma unroll
      for (int d0 = 0; d0 < 4; ++d0) { const unsigned pk = P0pk[(d0 >> 1) * 16 + r];
        const float p0v = __uint_as_float((d0 & 1) ? (pk & 0xffff0000u) : (pk << 16));
        const float xv = p0v - U.lam * (o[d0][r] * rli[r]); o[d0][r] = xv; ssq[r] += xv * xv; } }
#pragma unroll
    for (int r = 0; r < 16; ++r) {
#pragma unroll
      for (int m = 1; m < 32; m <<= 1) ssq[r] += __shfl_xor(ssq[r], m); }
    float* LS = L + 256;
    if (r32 == 0) {
#pragma unroll
      for (int r = 0; r < 16; ++r) LS[wid * 32 + crow(r, hi)] = ssq[r]; }
    __syncthreads();
    float sg[4];
#pragma unroll
    for (int d0 = 0; d0 < 4; ++d0) sg[d0] = U.subln[x * 128 + d0 * 32 + r32] * U.osc;
    bf16_t* Ow = U.O + (long)(rg * QBLK) * U.ldo + x * 128;
#pragma unroll
    for (int r = 0; r < 16; ++r) { const int orow = crow(r, hi);
      const float rstd = 1.0f / sqrtf((LS[rg * 32 + orow] + LS[(rg + 4) * 32 + orow]) * (1.0f / 256.0f) + 1e-6f);
#pragma unroll
      for (int d0 = 0; d0 < 4; d0 += 2) { const unsigned w = cvtpk(o[d0][r] * rstd * sg[d0], o[d0 + 1][r] * rstd * sg[d0 + 1]);
        Ow[(long)orow * U.ldo + d0 * 32 + r32] = (bf16_t)(w & 0xffffu); Ow[(long)orow * U.ldo + (d0 + 1) * 32 + r32] = (bf16_t)(w >> 16); } }
  }
  __syncthreads();
#undef B_TILE
#undef B_LD8
#undef B_DMAK
#undef B_DMAV
#undef B_END
#undef B_LOADK
#undef B_LOADV
#undef B_WRITEK
#undef B_WRITEV
#undef B_QK
#undef B_SM_EXP
#undef B_SM_PUB
#undef B_PV_SM
#undef B_PV
}
__device__ __forceinline__ void attb_unit(const UnitB& U, char* lds, const int wave_id) {
  unsigned P0pk[32];
  attb_pass<0>(U, lds, wave_id, P0pk);
  attb_pass<1>(U, lds, wave_id, P0pk);
}
}

constexpr int DM = 2048, NCTX = 8192, NLAT = 32768, MTOK = 40960, DFF = 5632, NUP = 11264, DEPTH = 4, NWAVES = 8;
constexpr float EPS = 1e-6f;
constexpr size_t OUT_SAK = 83886080, OUT_SAV = 92274688, OUT_SBK = 100663296, OUT_SBV = 134217728, OUT_END = 167772160;
constexpr size_t MiB = 1u << 20;
constexpr size_t WS_CTL = 0, CTL_ZERO_BYTES = 1 * MiB;
constexpr size_t WS_MOD = 1 * MiB;
constexpr size_t WS_ROPE = 3 * MiB;
constexpr size_t WS_CAK = 4 * MiB, WS_CAV = 12 * MiB, WS_CBK = 20 * MiB, WS_CBV = 52 * MiB;
constexpr size_t WS_WQKV = 84 * MiB, WS_WO = 108 * MiB, WS_WUP = 116 * MiB, WS_WDN = 160 * MiB;
constexpr size_t WS_H = 184 * MiB;
constexpr size_t WS_BIG = 344 * MiB;
constexpr size_t WS_QKV = WS_BIG;
constexpr size_t WS_PART = WS_BIG + 480 * MiB;
constexpr size_t WS_EDGE = WS_BIG;
constexpr size_t WS_ACT = WS_BIG + 440 * MiB;
constexpr size_t WS_A2 = WS_BIG + 32 * MiB;
constexpr size_t WS_ROWSS = WS_BIG + 880 * MiB;
constexpr size_t WS_SHW = WS_ROWSS + 12 * MiB;
constexpr size_t WS_WDN2 = WS_SHW + 3 * MiB;
constexpr size_t WS_END = WS_WDN2 + 22 * MiB;
constexpr int CW_KMAX = 64;
constexpr int CW_BAR = 4096;
constexpr int NPH_LAYER = 8, NPHASES = 1 + DEPTH * NPH_LAYER;
constexpr int RING_OFF = 0, RING_BYTES = 131072;
constexpr int LDSCTL_OFF = RING_BYTES, MISC_OFF = LDSCTL_OFF + 320;
constexpr int XG_OFF = LDSCTL_OFF + 14336;
constexpr int RED_OFF = LDSCTL_OFF + 2048;
constexpr int LDS_BYTES = 147456;

#define GAS __attribute__((address_space(1)))
#define LAS __attribute__((address_space(3)))
typedef unsigned short bf16;
typedef unsigned v4u __attribute__((ext_vector_type(4)));
typedef unsigned v2u __attribute__((ext_vector_type(2)));
typedef float f32x4 __attribute__((ext_vector_type(4)));
typedef float f32x2 __attribute__((ext_vector_type(2)));
typedef GAS unsigned gu32;
#define LDS_WAIT() asm volatile("s_waitcnt lgkmcnt(0)" ::: "memory")
__device__ __forceinline__ unsigned f2bf(float f) { unsigned u = __builtin_bit_cast(unsigned, f); return (u + 0x7fffu + ((u >> 16) & 1u)) >> 16; }
__device__ __forceinline__ unsigned pk2(float lo, float hi) { return f2bf(lo) | (f2bf(hi) << 16); }
__device__ __forceinline__ float bf_lo(unsigned w) { return __builtin_bit_cast(float, w << 16); }
__device__ __forceinline__ float bf_hi(unsigned w) { return __builtin_bit_cast(float, w & 0xffff0000u); }

#define XB_TMO      128
#define XB_XCNT(j)  (256  + 64 * (j))
#define XB_XSUB(j)  (1280 + 64 * (j))
#define XB_XGEN(j)  (2304 + 64 * (j))
#define XB_TOP      3328
#define XB_TOPGEN   3392
#define XCD_BAR_WORDS 3456
#define XB_SPIN_CAP (1u << 18)

__device__ __forceinline__ unsigned xb_ld(unsigned* p)              { return __hip_atomic_load(p, __ATOMIC_RELAXED, __HIP_MEMORY_SCOPE_AGENT); }
__device__ __forceinline__ unsigned xb_add(unsigned* p, unsigned v) { return __hip_atomic_fetch_add(p, v, __ATOMIC_RELAXED, __HIP_MEMORY_SCOPE_AGENT); }
__device__ __forceinline__ unsigned xb_xcc_id() { return (unsigned)__builtin_amdgcn_s_getreg((3 << 11) | 20) & 0xFu; }
#define XB_SPIN(cond, bar) do { unsigned _sp = 0; while (cond) { __builtin_amdgcn_s_sleep(1); \
    if ((++_sp & 255u) == 0u) { if (xb_ld(&(bar)[XB_TMO])) break; if (_sp > XB_SPIN_CAP) { atomicAdd(&(bar)[XB_TMO], 1u); break; } } } } while (0)

struct XcdBarrier {
    unsigned* bar; unsigned x;
    volatile LAS unsigned* st;
};

__device__ __forceinline__ XcdBarrier xcd_barrier_post(unsigned* bar, volatile LAS unsigned* st) {
    XcdBarrier b; b.bar = bar; b.x = xb_xcc_id(); b.st = st;
    if (threadIdx.x == 0) st[2] = xb_add(&bar[XB_XCNT(b.x)], 1u);
    return b;
}
__device__ __forceinline__ void xcd_barrier_complete(unsigned* bar, unsigned x, unsigned& nloc, unsigned& nx) {
    const unsigned G = gridDim.x * gridDim.y * gridDim.z;
    unsigned sum, cnt, mine, sp = 0u;
    for (;;) {
        sum = 0u; cnt = 0u; mine = 0u;
#pragma unroll
        for (unsigned j = 0; j < 16; ++j) { const unsigned c = xb_ld(&bar[XB_XCNT(j)]); sum += c; cnt += (c > 0u) ? 1u : 0u; mine = (j == x) ? c : mine; }
        if (sum == G) break;
        __builtin_amdgcn_s_sleep(1);
        if ((++sp & 255u) == 0u) { if (xb_ld(&bar[XB_TMO])) break; if (sp > XB_SPIN_CAP) { atomicAdd(&bar[XB_TMO], 1u); break; } }
    }
    nloc = mine > 0u ? mine : 1u; nx = cnt > 0u ? cnt : 1u;
}

__device__ __forceinline__ void xcd_barrier(const XcdBarrier& b, const bool is_t0  ) {
    asm volatile("s_waitcnt vmcnt(0)" ::: "memory");
    __syncthreads();
    if (is_t0) {
        unsigned* bar = b.bar;
        __builtin_amdgcn_s_waitcnt(0);
        unsigned nloc = b.st[0], nx = b.st[1];
        if (nloc == 0u) { xcd_barrier_complete(bar, b.x, nloc, nx); b.st[0] = nloc; b.st[1] = nx; }
        const unsigned old = xb_add(&bar[XB_XSUB(b.x)], 1u);
        const unsigned gen = old / nloc;
        if (old + 1u == (gen + 1u) * nloc) {
            __builtin_amdgcn_fence(__ATOMIC_RELEASE, "agent");
            asm volatile("s_waitcnt vmcnt(0)" ::: "memory");
            const unsigned og = xb_add(&bar[XB_TOP], 1u);
            const unsigned tg = og / nx;
            if (og + 1u == (tg + 1u) * nx) xb_add(&bar[XB_TOPGEN], 1u);
            else XB_SPIN(xb_ld(&bar[XB_TOPGEN]) == tg, bar);
            __builtin_amdgcn_fence(__ATOMIC_ACQUIRE, "agent");
            xb_add(&bar[XB_XGEN(b.x)], 1u);
            asm volatile("s_waitcnt vmcnt(0)" ::: "memory");
        } else {
            XB_SPIN(xb_ld(&bar[XB_XGEN(b.x)]) == gen, bar);
            __builtin_amdgcn_fence(__ATOMIC_ACQUIRE, "agent");
            asm volatile("s_waitcnt vmcnt(0)" ::: "memory");
        }
    }
    __syncthreads();
}
struct Args { const float* in[30]; float* out; unsigned char* ws; double rc[32]; double rs[32]; int ph_lo, ph_hi, li, pad; };
struct Frame {
    LAS unsigned char* lds;
    volatile LAS unsigned* MISC;
    gu32* ctl;
    int vcu, G, wave, cg;
    float* out; unsigned char* ws;
};
template <class T> __device__ __forceinline__ T* opaque_ptr(T* p) { size_t z = 0; asm volatile("" : "+s"(z)); return (T*)((char*)p + z); }
__device__ __forceinline__ int opaque_int(int v) { asm volatile("" : "+s"(v)); return v; }
#define PHASE_IDS() int tid_ = (F.wave << 6) | (int)__builtin_amdgcn_mbcnt_hi(~0u, __builtin_amdgcn_mbcnt_lo(~0u, 0u)); asm volatile("" : "+v"(tid_)); const int tid = tid_, lane = tid & 63, wave = F.wave; (void)tid; (void)lane; (void)wave; unsigned char* const WS = opaque_ptr(F.ws); float* const OUT = opaque_ptr(F.out); (void)WS; (void)OUT
__device__ __forceinline__ float wave_sum(float v) {
#pragma unroll
    for (int o = 1; o < 64; o <<= 1) v += __shfl_xor(v, o);
    return v;
}
template <int MODE = 0>
__device__ __forceinline__ void transpose_item(const float* W, int K, int N, bf16* WT, LAS float* scr, int item, int lane, int nqk = 0) {
    const int nblk = N / 64, kb = item / nblk, nb = item % nblk, k0 = 32 * kb, n0 = 64 * nb;
    int r0 = n0; if (MODE == 1) { const int f = n0 < DFF ? n0 : n0 - DFF; r0 = 256 * (f >> 7) + (f & 127) + (n0 < DFF ? 0 : 128); }
    const bool qkperm = (MODE == 2) && ((n0 >> 7) < nqk);
    const float* src = W + (size_t)k0 * N + n0 + lane;
    float v[32];
#pragma unroll
    for (int i = 0; i < 32; ++i) v[i] = src[(size_t)i * N];
#pragma unroll
    for (int i = 0; i < 32; ++i) scr[i * 65 + lane] = v[i];
    LDS_WAIT(); asm volatile("" ::: "memory");
    const int c = lane & 3;
#pragma unroll
    for (int j = 0; j < 4; ++j) { const int n = (lane >> 2) + 16 * j; const LAS float* s = scr + (8 * c) * 65 + n;
        v4u o; o.x = pk2(s[0 * 65], s[1 * 65]); o.y = pk2(s[2 * 65], s[3 * 65]); o.z = pk2(s[4 * 65], s[5 * 65]); o.w = pk2(s[6 * 65], s[7 * 65]);
        const int row = qkperm ? (n0 & ~127) + pg8::qk_row_of_dim((n0 & 127) + n) : r0 + n;
        *(GAS v4u*)(WT + (size_t)row * K + k0 + 8 * c) = o; }
    LDS_WAIT(); asm volatile("" ::: "memory");
}

__device__ __forceinline__ void ph_prologue(Frame& F, const Args& A) {
    PHASE_IDS();
    LAS float* S = (LAS float*)(F.lds + RING_OFF);
    LAS float* red = (LAS float*)(F.lds + RING_OFF + 9 * 2048 * 4);
    const float* c = A.in[6]; const float* cctx = A.in[7]; const float* ada_w = A.in[8]; const float* ada_b = A.in[9];
    float* mod = (float*)(WS + WS_MOD);
    for (int idx = tid; idx < 9 * 2048; idx += 512) { const int r = idx >> 11, k = idx & 2047; const float cv = (r < 8) ? c[r * 2048 + k] : cctx[k]; S[idx] = cv / (1.0f + __expf(-cv)); }
    __syncthreads();
    for (int item = blockIdx.x; item < 4 * 64; item += F.G) {
        const int l = item >> 6, n0 = (item & 63) * 192, k0 = wave * 256;
        f32x4 acc[9];
#pragma unroll
        for (int r = 0; r < 9; ++r) acc[r] = (f32x4){0.f, 0.f, 0.f, 0.f};
        if (lane < 48) {
            const GAS float* W = (const GAS float*)(ada_w + ((size_t)l * 2048 + k0) * 12288 + n0 + 4 * lane);
            f32x4 wa[8], wb[8];
#define GV_LOAD(WW, kk_) do { _Pragma("unroll") for (int i_ = 0; i_ < 8; ++i_) WW[i_] = *(const GAS f32x4*)(W + (size_t)((kk_) + i_) * 12288); asm volatile("" ::: "memory"); } while (0)
#define GV_FMA(WW, kk_) do { _Pragma("unroll") for (int r = 0; r < 9; ++r) { const f32x4 s0 = *(const LAS f32x4*)(S + r * 2048 + k0 + (kk_)), s1 = *(const LAS f32x4*)(S + r * 2048 + k0 + (kk_) + 4); \
                acc[r] += WW[0] * s0.x + WW[1] * s0.y + WW[2] * s0.z + WW[3] * s0.w; acc[r] += WW[4] * s1.x + WW[5] * s1.y + WW[6] * s1.z + WW[7] * s1.w; } } while (0)
            GV_LOAD(wa, 0);
            for (int kk = 0; kk < 256; kk += 16) {
                GV_LOAD(wb, kk + 8);
                GV_FMA(wa, kk);
                GV_LOAD(wa, kk + 16 < 256 ? kk + 16 : kk);
                GV_FMA(wb, kk + 8);
            }
#undef GV_LOAD
#undef GV_FMA
#pragma unroll
            for (int r = 0; r < 9; ++r) *(LAS f32x4*)(red + (wave * 9 + r) * 192 + 4 * lane) = acc[r];
        }
        __syncthreads();
        for (int idx = tid; idx < 9 * 192; idx += 512) { const int r = idx / 192, cc = idx % 192; float s = 0.f;
#pragma unroll
            for (int w = 0; w < 8; ++w) s += red[(w * 9 + r) * 192 + cc];
            mod[(size_t)(l * 9 + r) * 12288 + n0 + cc] = s + ada_b[l * 12288 + n0 + cc]; }
        __syncthreads();
    }
    if (blockIdx.x == 1 && wave < 2) { const int jj = wave; const float linit = 0.8f - 0.6f * expf(-0.3f * (float)(2 * jj + 1));
        const float* q1 = A.in[20] + jj * 128; const float* k1 = A.in[21] + jj * 128; const float* q2 = A.in[22] + jj * 128; const float* k2 = A.in[23] + jj * 128;
        const float d1 = wave_sum(q1[lane] * k1[lane] + q1[lane + 64] * k1[lane + 64]), d2 = wave_sum(q2[lane] * k2[lane] + q2[lane + 64] * k2[lane + 64]);
        if (lane == 0) { float* ls = (float*)(WS + WS_ROPE + 32768); ls[2 * jj] = expf(d1) - expf(d2) + linit; ls[2 * jj + 1] = 1.0f - linit; } }
    if (blockIdx.x == 0 && tid < 32) {
        double c1 = 1.0, s1 = 0.0;
#pragma unroll
        for (int i = 0; i < 32; ++i) if (tid == i) { c1 = A.rc[i]; s1 = A.rs[i]; }
        double cc = 1.0, ss = 0.0; float* tab = (float*)(WS + WS_ROPE);
        for (int p = 0; p < 64; ++p) { tab[p * 64 + tid] = (float)cc; tab[p * 64 + 32 + tid] = (float)ss; const double cn = cc * c1 - ss * s1, sn = ss * c1 + cc * s1; cc = cn; ss = sn; }
    }
    { constexpr size_t NA = 4194304 / 8, NB = 16777216 / 8, TOT = 2 * NA + 2 * NB; float kmx[4] = {0.f, 0.f, 0.f, 0.f};
      const size_t stride = (size_t)F.G * 512;
      for (size_t i0 = (size_t)blockIdx.x * 512 + tid; i0 < TOT; i0 += 4 * stride) {
          f32x4 a4[4], b4[4];
#pragma unroll
          for (int u = 0; u < 4; ++u) { size_t j = i0 + u * stride; if (j >= TOT) j = i0; const float* src;
              if (j < NA) { src = A.in[2]; } else if (j < 2 * NA) { j -= NA; src = A.in[3]; } else if (j < 2 * NA + NB) { j -= 2 * NA; src = A.in[4]; } else { j -= 2 * NA + NB; src = A.in[5]; }
              a4[u] = *(const GAS f32x4*)(src + j * 8); b4[u] = *(const GAS f32x4*)(src + j * 8 + 4); }
          asm volatile("" ::: "memory");
#pragma unroll
          for (int u = 0; u < 4; ++u) { const size_t i = i0 + u * stride; if (i < TOT) { size_t j = i; bf16* dst;
              if (j < NA) { dst = (bf16*)(WS + WS_CAK); } else if (j < 2 * NA) { j -= NA; dst = (bf16*)(WS + WS_CAV); } else if (j < 2 * NA + NB) { j -= 2 * NA; dst = (bf16*)(WS + WS_CBK); } else { j -= 2 * NA + NB; dst = (bf16*)(WS + WS_CBV); }
              const f32x4 a = a4[u], b = b4[u];
              v4u o; o.x = pk2(a.x, a.y); o.y = pk2(a.z, a.w); o.z = pk2(b.x, b.y); o.w = pk2(b.z, b.w);
              *(GAS v4u*)(dst + j * 8) = o;
              float ss = (a.x * a.x + a.y * a.y) + (a.z * a.z + a.w * a.w) + (b.x * b.x + b.y * b.y) + (b.z * b.z + b.w * b.w);
              ss += __shfl_xor(ss, 1); ss += __shfl_xor(ss, 2); ss += __shfl_xor(ss, 4); ss += __shfl_xor(ss, 8);
              const bool isAk = i < NA, isBk = i >= 2 * NA && i < 2 * NA + NB;
              if (isAk || isBk) { const size_t vecidx = j >> 4; const int w_ = (isAk ? 0 : 2) + (isAk ? (int)((vecidx / (512 * 4)) & 1) : (int)((vecidx / (512 * 16)) & 1));
                  kmx[0] = fmaxf(kmx[0], w_ == 0 ? ss : 0.f); kmx[1] = fmaxf(kmx[1], w_ == 1 ? ss : 0.f); kmx[2] = fmaxf(kmx[2], w_ == 2 ? ss : 0.f); kmx[3] = fmaxf(kmx[3], w_ == 3 ? ss : 0.f); } } } }
      LAS float* kred = (LAS float*)(F.lds + RING_OFF);
      __syncthreads();
#pragma unroll
      for (int q = 0; q < 4; ++q) { float m = kmx[q];
#pragma unroll
          for (int o = 1; o < 64; o <<= 1) m = fmaxf(m, __shfl_xor(m, o));
          if (lane == 0) kred[wave * 4 + q] = m; }
      __syncthreads();
      if (tid < 4) { float m = 0.f;
#pragma unroll
          for (int w = 0; w < 8; ++w) m = fmaxf(m, kred[w * 4 + tid]);
          if (m > 0.f) atomicMax((unsigned*)F.ctl + CW_KMAX + tid, __float_as_uint(m)); }
      __syncthreads(); }
}

__device__ __forceinline__ void adaln0_rows(Frame& F, const Args& A) {
    PHASE_IDS();
    const int gw = opaque_int(F.vcu * NWAVES + wave), NGW = F.G * NWAVES;
    const float* g = A.in[10];
    const float* modl = (const float*)(WS + WS_MOD);
    bf16* H = (bf16*)(WS + WS_H); float* rowss = (float*)(WS + WS_ROWSS);
#define AR_LOAD(v, row_) do { const int rw_ = (row_); const GAS float* xr_ = (const GAS float*)(rw_ < NCTX ? A.in[0] + (size_t)rw_ * DM : A.in[1] + (size_t)(rw_ - NCTX) * DM) + 4 * lane; \
        _Pragma("unroll") for (int j_ = 0; j_ < 8; ++j_) v[j_] = *(const GAS f32x4*)(xr_ + 256 * j_); asm volatile("" ::: "memory"); } while (0)
#define AR_PROC(v, row_) do { const int rw_ = (row_); const int cond_ = rw_ < NCTX ? 8 : ((rw_ - NCTX) >> 12); const float* sc_ = modl + (size_t)cond_ * 12288 + DM; float ss_ = 0.f; \
        _Pragma("unroll") for (int j_ = 0; j_ < 8; ++j_) { ss_ += (v[j_].x * v[j_].x + v[j_].y * v[j_].y) + (v[j_].z * v[j_].z + v[j_].w * v[j_].w); *(GAS f32x4*)(OUT + (size_t)rw_ * DM + 4 * lane + 256 * j_) = v[j_]; } \
        ss_ = wave_sum(ss_); \
        if (lane < 8) rowss[(size_t)rw_ * 8 + lane] = lane == 0 ? ss_ : 0.f; \
        _Pragma("unroll") for (int j_ = 0; j_ < 8; ++j_) { const int col_ = 4 * lane + 256 * j_; \
            const f32x4 gg_ = *(const f32x4*)(g + col_), s1_ = *(const f32x4*)(sc_ + col_); \
            const f32x4 y_ = v[j_] * gg_ * (s1_ + 1.0f); \
            v2u o_; o_.x = pk2(y_.x, y_.y); o_.y = pk2(y_.z, y_.w); \
            *(GAS v2u*)(H + (size_t)rw_ * DM + col_) = o_; } } while (0)
    int row = gw;
    f32x4 va[8], vb[8];
    if (row < MTOK) AR_LOAD(va, row);
    while (row < MTOK) {
        const int r1 = row + NGW;
        AR_LOAD(vb, r1 < MTOK ? r1 : row);
        AR_PROC(va, row);
        if (r1 >= MTOK) break;
        const int r2 = r1 + NGW;
        AR_LOAD(va, r2 < MTOK ? r2 : r1);
        AR_PROC(vb, r1);
        row = r2;
    }
#undef AR_LOAD
#undef AR_PROC
}
__device__ __forceinline__ void shw_gemv_all(Frame& F, const Args& A) {
    PHASE_IDS();
    LAS float* S = (LAS float*)(F.lds + RING_OFF); LAS float* red = (LAS float*)(F.lds + RING_OFF + 9 * 2048 * 4);
    for (int item = blockIdx.x; item < 248; item += F.G) {
        int layer, isup, cg;
        if (item < 72) { isup = 0; int r = item; layer = 0; while (true) { const int n = (layer & 1) ? 24 : 12; if (r < n) break; r -= n; ++layer; } cg = r; }
        else { isup = 1; layer = (item - 72) / 44; cg = (item - 72) % 44; }
        const int j = layer >> 1; const bool isB = layer & 1; const int N = isup ? NUP : (isB ? 6144 : 3072), nqk = isB ? 32 : 20;
        const float* W = isup ? A.in[26] + (size_t)layer * DM * NUP : (isB ? A.in[17] + (size_t)j * DM * 6144 : A.in[12] + (size_t)j * DM * 3072);
        const float* sh = (const float*)(WS + WS_MOD) + (size_t)layer * 9 * 12288 + (isup ? 3 * DM : 0);
        float* out = (float*)(WS + WS_SHW) + (size_t)layer * 9 * 17408 + (isup ? 9 * 6144 : 0);
        __syncthreads();
        for (int idx = tid; idx < 9 * 2048; idx += 512) S[idx] = sh[(size_t)(idx >> 11) * 12288 + (idx & 2047)];
        __syncthreads();
        const int n0 = cg * 256, k0 = wave * 256;
        const GAS float* Wp = (const GAS float*)(W + (size_t)k0 * N + n0 + 4 * lane);
        f32x4 acc[9];
#pragma unroll
        for (int r = 0; r < 9; ++r) acc[r] = (f32x4){0.f, 0.f, 0.f, 0.f};
        { f32x4 wa[8], wb[8];
#define GV_LOAD(WW, kk_) do { _Pragma("unroll") for (int i_ = 0; i_ < 8; ++i_) WW[i_] = *(const GAS f32x4*)(Wp + (size_t)((kk_) + i_) * N); asm volatile("" ::: "memory"); } while (0)
#define GV_FMA(WW, kk_) do { _Pragma("unroll") for (int r = 0; r < 9; ++r) { const f32x4 s0 = *(const LAS f32x4*)(S + r * 2048 + k0 + (kk_)), s1 = *(const LAS f32x4*)(S + r * 2048 + k0 + (kk_) + 4); \
            acc[r] += WW[0] * s0.x + WW[1] * s0.y + WW[2] * s0.z + WW[3] * s0.w; acc[r] += WW[4] * s1.x + WW[5] * s1.y + WW[6] * s1.z + WW[7] * s1.w; } } while (0)
          GV_LOAD(wa, 0);
          for (int kk = 0; kk < 256; kk += 16) {
              GV_LOAD(wb, kk + 8);
              GV_FMA(wa, kk);
              GV_LOAD(wa, kk + 16 < 256 ? kk + 16 : kk);
              GV_FMA(wb, kk + 8);
          }
#undef GV_LOAD
#undef GV_FMA
        }
#pragma unroll
        for (int half = 0; half < 2; ++half) {
            if ((lane >> 5) == half) {
#pragma unroll
                for (int r = 0; r < 9; ++r) *(LAS f32x4*)(red + (wave * 9 + r) * 128 + 4 * (lane & 31)) = acc[r]; }
            __syncthreads();
            for (int idx = tid; idx < 9 * 128; idx += 512) { const int r = idx >> 7, cc = idx & 127, n = n0 + half * 128 + cc; float s = 0.f;
#pragma unroll
                for (int w = 0; w < 8; ++w) s += red[(w * 9 + r) * 128 + cc];
                int lc = n;
                if (isup) { const int f = n < DFF ? n : n - DFF; lc = 256 * (f >> 7) + (f & 127) + (n < DFF ? 0 : 128); }
                else if ((n >> 7) < nqk) lc = (n & ~127) + pg8::qk_row_of_dim(n & 127);
                out[(size_t)r * N + lc] = s; }
            __syncthreads();
        }
    }
}
struct CvtItem { const float* W; bf16* WT; int K, N, item, mode, nqk; };
#define CVT_LOAD(v, d) do { const int nblk_ = (d).N / 64, kb_ = (d).item / nblk_, nb_ = (d).item % nblk_; const GAS float* src_ = (const GAS float*)((d).W + (size_t)(32 * kb_) * (d).N + 64 * nb_) + lane; \
    _Pragma("unroll") for (int i_ = 0; i_ < 32; ++i_) v[i_] = src_[(size_t)i_ * (d).N]; asm volatile("" ::: "memory"); } while (0)
#define CVT_STORE(v, d) do { const int nblk_ = (d).N / 64, kb_ = (d).item / nblk_, nb_ = (d).item % nblk_, k0_ = 32 * kb_, n0_ = 64 * nb_; \
    int r0_ = n0_; if ((d).mode == 1) { const int f_ = n0_ < DFF ? n0_ : n0_ - DFF; r0_ = 256 * (f_ >> 7) + (f_ & 127) + (n0_ < DFF ? 0 : 128); } \
    const bool qkperm_ = ((d).mode == 2) && ((n0_ >> 7) < (d).nqk); \
    _Pragma("unroll") for (int i_ = 0; i_ < 32; ++i_) scr[i_ * 65 + lane] = v[i_]; \
    LDS_WAIT(); asm volatile("" ::: "memory"); \
    const int c_ = lane & 3; \
    _Pragma("unroll") for (int j_ = 0; j_ < 4; ++j_) { const int n_ = (lane >> 2) + 16 * j_; const LAS float* s_ = scr + (8 * c_) * 65 + n_; \
        v4u o_; o_.x = pk2(s_[0 * 65], s_[1 * 65]); o_.y = pk2(s_[2 * 65], s_[3 * 65]); o_.z = pk2(s_[4 * 65], s_[5 * 65]); o_.w = pk2(s_[6 * 65], s_[7 * 65]); \
        const int row_ = qkperm_ ? (n0_ & ~127) + pg8::qk_row_of_dim((n0_ & 127) + n_) : r0_ + n_; \
        *(GAS v4u*)((d).WT + (size_t)row_ * (d).K + k0_ + 8 * c_) = o_; } \
    LDS_WAIT(); asm volatile("" ::: "memory"); } while (0)
__device__ __forceinline__ void convert_weights(Frame& F, const Args& A, int layer, int sel, int rank, int nrank) {
    PHASE_IDS();
    LAS float* scr = (LAS float*)(F.lds + RING_OFF + wave * 16384);
    const int gw = opaque_int(rank * NWAVES + wave), NGW = nrank * NWAVES;
    const int j = layer >> 1; const bool isB = layer & 1; const int NQ = isB ? 6144 : 3072;
    const float* Wqkv = isB ? A.in[17] + (size_t)j * DM * 6144 : A.in[12] + (size_t)j * DM * 3072;
    const float* Wo = (isB ? A.in[25] : A.in[16]) + (size_t)j * DM * DM;
    const float* Wup = A.in[26] + (size_t)layer * DM * NUP; const float* Wdn = A.in[29] + (size_t)layer * DFF * DM;
    const int I_Q = (sel & 1) ? (DM / 32) * (NQ / 64) : 0, I_O = (sel & 2) ? (DM / 32) * (DM / 64) : 0, I_U = (sel & 4) ? (DM / 32) * (NUP / 64) : 0, I_D = (sel & 8) ? (DFF / 32) * (DM / 64) : 0;
    const int NITEMS = I_Q + I_O + I_U + I_D;
    auto decode = [&](int it) -> CvtItem { CvtItem d; int r = it;
        if (r < I_Q) { d.W = Wqkv; d.WT = (bf16*)(WS + WS_WQKV); d.K = DM; d.N = NQ; d.item = r; d.mode = 2; d.nqk = isB ? 32 : 20; return d; } r -= I_Q;
        if (r < I_O) { d.W = Wo; d.WT = (bf16*)(WS + WS_WO); d.K = DM; d.N = DM; d.item = r; d.mode = 0; d.nqk = 0; return d; } r -= I_O;
        if (r < I_U) { d.W = Wup; d.WT = (bf16*)(WS + WS_WUP); d.K = DM; d.N = NUP; d.item = r; d.mode = 1; d.nqk = 0; return d; } r -= I_U;
        d.W = Wdn; d.WT = (bf16*)(WS + ((layer & 1) ? WS_WDN2 : WS_WDN)); d.K = DFF; d.N = DM; d.item = r; d.mode = 0; d.nqk = 0; return d; };
    int it = gw;
    float va[32], vb[32];
    if (it < NITEMS) { const CvtItem d = decode(it); CVT_LOAD(va, d); }
    while (it < NITEMS) {
        const int n1 = it + NGW;
        { const CvtItem d = decode(n1 < NITEMS ? n1 : it); CVT_LOAD(vb, d); }
        { const CvtItem d = decode(it); CVT_STORE(va, d); }
        if (n1 >= NITEMS) break;
        const int n2 = n1 + NGW;
        { const CvtItem d = decode(n2 < NITEMS ? n2 : n1); CVT_LOAD(va, d); }
        { const CvtItem d = decode(n1); CVT_STORE(vb, d); }
        it = n2;
    }
}

__device__ __forceinline__ void attention_phase(Frame& F, const Args& A, int layer, char* lds) {
    unsigned char* const WS = opaque_ptr(F.ws);
    const int j = layer >> 1; const bool isB = layer & 1;
    const bf16* QKV = (const bf16*)(WS + WS_QKV);
    const int nlat = 2048, nctx = 512, ntot = nlat + nctx;
    float mbound;
    { int lane = (int)__builtin_amdgcn_mbcnt_hi(~0u, __builtin_amdgcn_mbcnt_lo(~0u, 0u)); asm volatile("" : "+v"(lane));
      const float* gq = (isB ? A.in[18] : A.in[13]) + j * 128; const float* gk = (isB ? A.in[19] : A.in[14]) + j * 128;
      float mq = fmaxf(fabsf(gq[lane]), fabsf(gq[lane + 64])), mk = fmaxf(fabsf(gk[lane]), fabsf(gk[lane + 64]));
#pragma unroll
      for (int o = 1; o < 64; o <<= 1) { mq = fmaxf(mq, __shfl_xor(mq, o)); mk = fmaxf(mk, __shfl_xor(mk, o)); }
      const float kc = sqrtf(__uint_as_float(__hip_atomic_load((unsigned*)F.ctl + CW_KMAX + (isB ? 2 : 0) + j, __ATOMIC_RELAXED, __HIP_MEMORY_SCOPE_AGENT)));
      mbound = __builtin_amdgcn_readfirstlane(11.313708499f * mq * fmaxf(11.313708499f * mk, kc) * 1.01f); }
    const float lamB = ((const float*)(WS + WS_ROPE + 32768))[2 * j], oscB = ((const float*)(WS + WS_ROPE + 32768))[2 * j + 1];
    for (int u = F.vcu; u < ntot; u += F.G) {
        att::Unit U;
        if (!isB) {
            bf16* O = (bf16*)(WS + WS_H);
            const float* sink = A.in[15] + j * 16;
            U.ldq = 3072; U.ld0 = 3072; U.ld1 = 512; U.ldo = 2048; U.m_init = mbound;
            if (u < nlat) { const int qt = u & 15, h = (u >> 4) & 15, b = u >> 8, kvh = h >> 2;
                const int ks = (qt * 256 - 128) < 0 ? 0 : qt * 256 - 128, ke = (qt * 256 + 384) > 4096 ? 4096 : qt * 256 + 384;
                const size_t r0 = (size_t)NCTX + (size_t)b * 4096;
                U.Q = QKV + (r0 + qt * 256) * 3072 + h * 128; U.O = O + (r0 + qt * 256) * 2048 + h * 128;
                U.K0 = QKV + (r0 + ks) * 3072 + 2048 + kvh * 128; U.V0 = U.K0 + 512; U.n0 = (ke - ks) >> 6;
                const size_t cb = ((size_t)(b * 2 + j) * 512) * 512 + kvh * 128;
                U.K1 = (const bf16*)(WS + WS_CAK) + cb; U.V1 = (const bf16*)(WS + WS_CAV) + cb; U.n1 = 8;
                U.mask = 1; U.qpos0 = qt * 256; U.kpos0 = ks; U.l_init = __expf(sink[h] - mbound * att::SCALE);
            } else { const int uu = u - nlat, h = uu & 15, b = uu >> 4, kvh = h >> 2; const size_t r0 = (size_t)b * 256;
                U.Q = QKV + r0 * 3072 + h * 128; U.O = O + r0 * 2048 + h * 128;
                U.K0 = QKV + r0 * 3072 + 2048 + kvh * 128; U.V0 = U.K0 + 512; U.n0 = 4;
                U.K1 = U.K0; U.V1 = U.V0; U.n1 = 0; U.mask = 0; U.qpos0 = 0; U.kpos0 = 0; U.l_init = __expf(sink[h] - mbound * att::SCALE);
            }
        } else {
            { att::UnitB UB; UB.ldq = 6144; UB.ld0 = 6144; UB.ld1 = 2048; UB.ldo = 2048; UB.m_bound = mbound; UB.lam = lamB; UB.osc = oscB; UB.subln = A.in[24] + j * 256;
                size_t orow; int h;
                if (u < 2048) { const int qt = u & 31; h = (u >> 5) & 7; const int b = u >> 8;
                    const size_t r0 = (size_t)NCTX + (size_t)b * 4096; orow = r0 + qt * 128;
                    UB.Q = QKV + orow * 6144 + (h * 2) * 128;
                    UB.K0 = QKV + r0 * 6144 + 2048 + (h * 2) * 128; UB.V0 = QKV + r0 * 6144 + 4096 + h * 256; UB.n0 = 64;
                    const size_t cb = ((size_t)(b * 2 + j) * 512) * 2048;
                    UB.K1 = (const bf16*)(WS + WS_CBK) + cb + (h * 2) * 128; UB.V1 = (const bf16*)(WS + WS_CBV) + cb + h * 256; UB.n1 = 8;
                } else { const int uu = u - 2048, qt = uu & 1; h = (uu >> 1) & 7; const int b = uu >> 4; const size_t r0 = (size_t)b * 256; orow = r0 + qt * 128;
                    UB.Q = QKV + orow * 6144 + (h * 2) * 128;
                    UB.K0 = QKV + r0 * 6144 + 2048 + (h * 2) * 128; UB.V0 = QKV + r0 * 6144 + 4096 + h * 256; UB.n0 = 4;
                    UB.K1 = UB.K0; UB.V1 = UB.V0; UB.n1 = 0;
                }
                UB.O = (bf16*)(WS + WS_H) + orow * 2048 + h * 256;
                att::attb_unit(UB, lds, F.wave);
            }
            continue;
        }
        att::attn_unit(U, lds, F.wave);
    }
}

__device__ __forceinline__ void diff_combine(Frame& F, const Args& A, int layer) {
    PHASE_IDS();
    const int gw = F.vcu * NWAVES + wave, NGW = F.G * NWAVES; const int j = layer >> 1;
    const float linit = 0.8f - 0.6f * expf(-0.3f * (float)layer);
    float d1, d2;
    { const float* q1 = A.in[20] + j * 128; const float* k1 = A.in[21] + j * 128; const float* q2 = A.in[22] + j * 128; const float* k2 = A.in[23] + j * 128;
      d1 = wave_sum(q1[lane] * k1[lane] + q1[lane + 64] * k1[lane + 64]); d2 = wave_sum(q2[lane] * k2[lane] + q2[lane + 64] * k2[lane + 64]); }
    const float lam = expf(d1) - expf(d2) + linit, osc = 1.0f - linit;
    const f32x4 sg = *(const f32x4*)(A.in[24] + j * 256 + 4 * lane);
    const bf16* P0 = (const bf16*)(WS + WS_PART); const bf16* P1 = P0 + (size_t)MTOK * 2048; bf16* O = (bf16*)(WS + WS_H);
    for (int it = gw; it < MTOK * 8; it += NGW) {
        const size_t off = (size_t)it * 256 + 4 * lane;
        const v2u a = *(const v2u*)(P0 + off), b = *(const v2u*)(P1 + off);
        const float x0 = bf_lo(a.x) - lam * bf_lo(b.x), x1 = bf_hi(a.x) - lam * bf_hi(b.x), x2 = bf_lo(a.y) - lam * bf_lo(b.y), x3 = bf_hi(a.y) - lam * bf_hi(b.y);
        const float rstd = osc / sqrtf(wave_sum((x0 * x0 + x1 * x1) + (x2 * x2 + x3 * x3)) * (1.0f / 256.0f) + EPS);
        v2u o; o.x = pk2(x0 * rstd * sg.x, x1 * rstd * sg.y); o.y = pk2(x2 * rstd * sg.z, x3 * rstd * sg.w);
        *(v2u*)(O + off) = o;
    }
}

__device__ __forceinline__ void convglu_fixup(Frame& F, const Args& A, int layer) {
    PHASE_IDS();
    const float* EDGE = (const float*)(WS + WS_EDGE); bf16* ACT = (bf16*)(WS + WS_ACT);
    const float* cw = A.in[27] + (size_t)layer * 3 * DFF; const float* cb = A.in[28] + (size_t)layer * DFF;
    constexpr int NF4 = DFF / 4;
    for (int it = blockIdx.x * 512 + tid; it < 120 * NF4; it += F.G * 512) {
        const int bd = it / NF4, f = (it % NF4) * 4, pm = 32 + (bd / 15) * 16 + (bd % 15);
        const float* el = EDGE + (size_t)pm * 6 * DFF + f; const float* er = el + 6 * DFF;
        const f32x4 gA1 = *(const f32x4*)(el), gA = *(const f32x4*)(el + DFF), vA = *(const f32x4*)(el + 2 * DFF);
        const f32x4 gB = *(const f32x4*)(er + 3 * DFF), gB1 = *(const f32x4*)(er + 4 * DFF), vB = *(const f32x4*)(er + 5 * DFF);
        const f32x4 w0 = *(const f32x4*)(cw + f), w1 = *(const f32x4*)(cw + DFF + f), w2 = *(const f32x4*)(cw + 2 * DFF + f), bb = *(const f32x4*)(cb + f);
        const f32x4 sa = w0 * gA1 + w1 * gA + w2 * gB + bb, sb = w0 * gA + w1 * gB + w2 * gB1 + bb;
        float a[4], b2[4];
#pragma unroll
        for (int k = 0; k < 4; ++k) { a[k] = sa[k] / (1.0f + __expf(-sa[k])) * vA[k]; b2[k] = sb[k] / (1.0f + __expf(-sb[k])) * vB[k]; }
        v2u oa, ob; oa.x = pk2(a[0], a[1]); oa.y = pk2(a[2], a[3]); ob.x = pk2(b2[0], b2[1]); ob.y = pk2(b2[2], b2[3]);
        *(v2u*)(ACT + (size_t)(pm * 256 + 255) * DFF + f) = oa; *(v2u*)(ACT + (size_t)(pm * 256 + 256) * DFF + f) = ob;
    }
}

__global__ void __launch_bounds__(NWAVES * 64, 2) mk_fwd(Args args) {
    extern __shared__ __attribute__((aligned(16))) unsigned char lds[];
    Frame F;
    F.lds = (LAS unsigned char*)lds;
    F.MISC = (volatile LAS unsigned*)(F.lds + MISC_OFF);
    F.wave = __builtin_amdgcn_readfirstlane((int)threadIdx.x >> 6);
    F.G = gridDim.x; { const int bx = blockIdx.x; F.vcu = (F.G % 8 == 0) ? (bx % 8) * (F.G / 8) + bx / 8 : bx; }
    F.cg = (int)blockIdx.x;
    F.ws = args.ws; F.out = args.out; F.ctl = (gu32*)(args.ws + WS_CTL);
    for (int u = threadIdx.x; u < (LDS_BYTES - LDSCTL_OFF) / 4; u += NWAVES * 64) ((LAS unsigned*)(F.lds + LDSCTL_OFF))[u] = 0u;
    __syncthreads();
    XcdBarrier bar = xcd_barrier_post((unsigned*)(F.ctl + CW_BAR) + args.li * XCD_BAR_WORDS, F.MISC + 8);
    const int lo = args.ph_lo, hi = args.ph_hi;
#ifndef SITES
#define SITES 0xFFFF
#endif
#define SITE(n) ((SITES >> (n)) & 1)
#ifndef DUPMASK
#define DUPMASK 0
#endif
#define NREP(n) (1 + ((DUPMASK >> (n)) & 1))
#define IN(k) (lo <= (k) && (k) < hi)
#define SEAM(k) do { if ((k) + 1 < hi) { const int t_ = (F.wave << 6) | (int)__builtin_amdgcn_mbcnt_hi(~0u, __builtin_amdgcn_mbcnt_lo(~0u, 0u)); XcdBarrier b_ = bar; b_.bar = opaque_ptr(b_.bar); xcd_barrier(b_, t_ == 0); } } while (0)

    if (SITE(12) && IN(0)) { ph_prologue(F, args); SEAM(0); }
    if (lo == 0 && hi > 1 && (F.G & 7) == 0) {
        if (threadIdx.x == 0) { unsigned pre = 0; for (unsigned jx = 0; jx < bar.x; ++jx) pre += xb_ld(&bar.bar[XB_XCNT(jx)]); F.MISC[11] = pre + F.MISC[10]; }
        __syncthreads();
        const int v = __builtin_amdgcn_readfirstlane((int)F.MISC[11]), per = F.G >> 3;
        F.vcu = v; F.cg = (v % per) * 8 + v / per;
    }

    for (int layer = 0; layer < DEPTH; ++layer) {
        const int pb = 1 + layer * NPH_LAYER; const bool isB = layer & 1; const int NQ = isB ? 6144 : 3072;
        if (SITE(0) && IN(pb + 0)) { if (layer == 0) { convert_weights(F, args, 0, 15, F.vcu, F.G); __syncthreads(); shw_gemv_all(F, args); adaln0_rows(F, args); SEAM(pb + 0); } }
        if (SITE(1) && IN(pb + 1)) { unsigned char* const WS = opaque_ptr(F.ws); float* const OUT = opaque_ptr(F.out); const int jl = layer >> 1;
            pg8::Gemm g{(const bf16*)(WS + WS_H), (const bf16*)(WS + WS_WQKV), MTOK, NQ, DM}; pg8::StaticOrder S; S.init(MTOK, NQ, F.G, F.cg, 8);
            pg8::EpiQKV E{(bf16*)(WS + WS_QKV), NQ, isB ? 32 : 20, (isB ? args.in[18] : args.in[13]) + jl * 128, (isB ? args.in[19] : args.in[14]) + jl * 128, (const float*)(WS + WS_ROPE),
                          OUT + (isB ? OUT_SBK : OUT_SAK), OUT + (isB ? OUT_SBV : OUT_SAV), isB ? 2048 : 512, jl, (LAS float*)(F.lds + RED_OFF),
                          (const float*)(WS + WS_ROWSS) + (size_t)(2 * layer) * MTOK * 8, (const float*)(WS + WS_SHW) + (size_t)layer * 9 * 17408};
            for (int rep = 0; rep < NREP(1); ++rep) pg8::gemm_phase<pg8::EpiQKV, pg8::StaticOrder, true, true>(F.lds + RING_OFF, g, S, E, F.wave);
            if (!isB && layer + 1 < DEPTH) { const int rem = S.nwg % F.G;
                if (rem == 0) convert_weights(F, args, layer + 1, 8, F.vcu, F.G); else if (F.cg >= rem) convert_weights(F, args, layer + 1, 8, F.cg - rem, F.G - rem); }
            SEAM(pb + 1);
        }
        if (SITE(3) && IN(pb + 2)) { for (int rep = 0; rep < NREP(3); ++rep) attention_phase(F, args, layer, (char*)lds + RING_OFF); SEAM(pb + 2); }
        if (SITE(5) && IN(pb + 4)) { unsigned char* const WS = opaque_ptr(F.ws); float* const OUT = opaque_ptr(F.out);
            pg8::Gemm g{(const bf16*)(WS + WS_H), (const bf16*)(WS + WS_WO), MTOK, DM, DM}; pg8::StaticOrder S; S.init(MTOK, DM, F.G, F.cg, 4);
            pg8::EpiGate E{OUT, (const float*)(WS + WS_MOD) + (size_t)layer * 9 * 12288 + 2 * DM,
                           (bf16*)(WS + WS_A2), args.in[11] + layer * DM, (const float*)(WS + WS_MOD) + (size_t)layer * 9 * 12288 + 4 * DM, (float*)(WS + WS_ROWSS) + (size_t)(2 * layer + 1) * MTOK * 8, (LAS float*)(F.lds + RED_OFF)};
            pg8::gemm_phase<pg8::EpiGate, pg8::StaticOrder, true, true>(F.lds + RING_OFF, g, S, E, F.wave);
            SEAM(pb + 4);
        }
        if (SITE(7) && IN(pb + 5)) { unsigned char* const WS = opaque_ptr(F.ws);
            pg8::Gemm g{(const bf16*)(WS + WS_A2), (const bf16*)(WS + WS_WUP), MTOK, NUP, DM}; pg8::StaticOrder S; S.init(MTOK, NUP, F.G, F.cg, 4);
            pg8::EpiConvGlu E{(bf16*)(WS + WS_ACT), args.in[27] + (size_t)layer * 3 * DFF, args.in[28] + (size_t)layer * DFF, (float*)(WS + WS_EDGE), (LAS float*)(F.lds + XG_OFF),
                               (const float*)(WS + WS_ROWSS) + (size_t)(2 * layer + 1) * MTOK * 8, (const float*)(WS + WS_SHW) + (size_t)layer * 9 * 17408 + 9 * 6144};
            pg8::gemm_phase<pg8::EpiConvGlu, pg8::StaticOrder, true, true, true>(F.lds + RING_OFF, g, S, E, F.wave);
            if (layer + 1 < DEPTH) { const int rem = S.nwg % F.G;
                if (rem == 0) convert_weights(F, args, layer + 1, 3, F.vcu, F.G); else if (F.cg >= rem) convert_weights(F, args, layer + 1, 3, F.cg - rem, F.G - rem); }
            SEAM(pb + 5);
        }
        if (SITE(8) && IN(pb + 6)) { convglu_fixup(F, args, layer); if (layer + 1 < DEPTH) convert_weights(F, args, layer + 1, isB ? 12 : 4, F.vcu, F.G); SEAM(pb + 6); }
        if (SITE(11) && IN(pb + 7)) { unsigned char* const WS = opaque_ptr(F.ws); float* const OUT = opaque_ptr(F.out);
            pg8::Gemm g{(const bf16*)(WS + WS_ACT), (const bf16*)(WS + ((layer & 1) ? WS_WDN2 : WS_WDN)), MTOK, DM, DFF}; pg8::StaticOrder S; S.init(MTOK, DM, F.G, F.cg, 4);
            const int nl = layer + 1 < DEPTH ? layer + 1 : layer; const bool last = layer + 1 == DEPTH;
            pg8::EpiGate E{OUT, (const float*)(WS + WS_MOD) + (size_t)layer * 9 * 12288 + 5 * DM,
                           last ? (bf16*)nullptr : (bf16*)(WS + WS_H), args.in[10] + nl * DM, (const float*)(WS + WS_MOD) + (size_t)nl * 9 * 12288 + 1 * DM, (float*)(WS + WS_ROWSS) + (size_t)(2 * nl) * MTOK * 8, (LAS float*)(F.lds + RED_OFF)};
            pg8::gemm_phase<pg8::EpiGate, pg8::StaticOrder, true, true>(F.lds + RING_OFF, g, S, E, F.wave);
            SEAM(pb + 7);
        }
    }
#undef IN
#undef SEAM
}

#ifndef MK_N_LAUNCHES
#define MK_N_LAUNCHES 1
#endif
extern "C" void kernel_launch(void* const* d_in, const int* in_sizes, int n_in, void* d_out, int out_size, void* d_ws, size_t ws_size, hipStream_t stream) {
    static int grid = 0;
    if (grid == 0) {
        if (n_in != 30 || (size_t)out_size != OUT_END || ws_size < WS_END) { fprintf(stderr, "kernel_launch: unexpected shapes: n_in %d out %d ws %zu (need %zu)\n", n_in, out_size, ws_size, (size_t)WS_END); grid = -1; return; }
        int dev = 0, cus = 0, per_cu = 0;
        if (hipGetDevice(&dev) != hipSuccess || hipDeviceGetAttribute(&cus, hipDeviceAttributeMultiprocessorCount, dev) != hipSuccess) { grid = -1; return; }
        if (hipFuncSetAttribute((const void*)mk_fwd, hipFuncAttributeMaxDynamicSharedMemorySize, LDS_BYTES) != hipSuccess) { fprintf(stderr, "kernel_launch: hipFuncSetAttribute failed\n"); grid = -1; return; }
        if (hipOccupancyMaxActiveBlocksPerMultiprocessor(&per_cu, (const void*)mk_fwd, NWAVES * 64, LDS_BYTES) != hipSuccess || per_cu < 1) { fprintf(stderr, "kernel_launch: occupancy query says %d blocks per CU\n", per_cu); }
        (void)hipGetLastError();
        grid = cus;
    }
    if (grid < 0) return;
    if (hipMemsetAsync((char*)d_ws + WS_CTL, 0, CTL_ZERO_BYTES, stream) != hipSuccess) return;
    Args a{};
    for (int i = 0; i < 30; ++i) a.in[i] = (const float*)d_in[i];
    a.out = (float*)d_out; a.ws = (unsigned char*)d_ws;
    for (int i = 0; i < 32; ++i) { const double th = pow(10000.0, -(double)i / 32.0); a.rc[i] = cos(th); a.rs[i] = sin(th); }
    constexpr int NL = MK_N_LAUNCHES;
    for (int li = 0; li < NL; ++li) {
        a.ph_lo = (NL == 1) ? 0 : li; a.ph_hi = (NL == 1) ? NPHASES : li + 1; a.li = li; a.pad = 0;
        hipLaunchKernelGGL(mk_fwd, dim3(grid), dim3(NWAVES * 64), LDS_BYTES, stream, a);
        const hipError_t le = hipPeekAtLastError();
        if (le != hipSuccess) { fprintf(stderr, "kernel_launch: launch %d failed: %s\n", li, hipGetErrorName(le)); break; }
    }
}
```
